# Optimizing an MI355X kernel written in HIP

```python
import jax, jax.numpy as jnp
from jax import lax
import numpy as np

D_MODEL = 1024
BATCH = 8
SEQ = 4096
DEPTH = 2

N_META = 16
N_FOURIER_GROUPS = 4
FOURIER_GROUP_DIM = D_MODEL // 8
FOURIER_WIDTH = N_FOURIER_GROUPS * FOURIER_GROUP_DIM
N_DELTA_HEADS = 4
HEAD_DIM = D_MODEL // 8
DELTA_WIDTH = N_DELTA_HEADS * HEAD_DIM
N_DIRS = 2
CONV_WIDTH = 5
CHUNK = 64
META_PAD = (-N_META) % CHUNK
D_FF = 4 * D_MODEL
DEEPNORM_ALPHA = (2 * DEPTH) ** 0.25
DEEPNORM_BETA = (8 * DEPTH) ** -0.25
LN_EPS = 1e-5
RMS_EPS = 1e-6
QKV_WIDTH = 3 * DELTA_WIDTH
GATE_WIDTH = 2 * D_MODEL
IN_SPLITS = (FOURIER_WIDTH, QKV_WIDTH, N_DIRS * N_DELTA_HEADS, N_DIRS * N_DELTA_HEADS, DELTA_WIDTH, GATE_WIDTH)
IN_WIDTH = sum(IN_SPLITS)

kernel_name = "fourier_gated_deltanet_deepnorm_encoder"


def layer_norm(x, g, b):
    xf = x.astype(jnp.float32)
    mu = jnp.mean(xf, -1, keepdims=True)
    var = jnp.mean(jnp.square(xf - mu), -1, keepdims=True)
    y = (xf - mu) * lax.rsqrt(var + LN_EPS) * g.astype(jnp.float32) + b.astype(jnp.float32)
    return y.astype(x.dtype)


def l2norm(t):
    return t * lax.rsqrt(jnp.sum(jnp.square(t), -1, keepdims=True) + 1e-6)


def fourier_mix(u):
    Bn, L, _ = u.shape
    ug = u.astype(jnp.float32).reshape(Bn, L, N_FOURIER_GROUPS, FOURIER_GROUP_DIM)
    y = jnp.fft.fft2(ug, axes=(1, 3), norm="ortho").real
    return y.reshape(Bn, L, FOURIER_WIDTH).astype(u.dtype)


def short_conv(x, w):
    C = x.shape[-1]
    y = lax.conv_general_dilated(
        x, w[:, None, :], window_strides=(1,),
        padding=[(CONV_WIDTH // 2, CONV_WIDTH // 2)],
        dimension_numbers=("NWC", "WIO", "NWC"), feature_group_count=C)
    return jax.nn.silu(y)


def chunked_gated_delta_rule(q, k, v, beta, g):
    R, Bn, H, Lp, dk = q.shape
    dv = v.shape[-1]
    N = Lp // CHUNK

    def chunks(t):
        return t.reshape(t.shape[:3] + (N, CHUNK) + t.shape[4:])

    q, k, v, beta, g = chunks(q), chunks(k), chunks(v), chunks(beta), chunks(g)
    g_cum = jnp.cumsum(g, axis=-1)
    idx = jnp.arange(CHUNK)
    lower_incl = idx[:, None] >= idx[None, :]
    lower_strict = idx[:, None] > idx[None, :]
    diff = g_cum[..., :, None] - g_cum[..., None, :]
    decay_incl = jnp.exp(jnp.where(lower_incl, diff, -jnp.inf))
    decay_strict = jnp.where(lower_strict, decay_incl, 0.0)

    k_beta = k * beta[..., None]
    v_beta = v * beta[..., None]
    l_mat = jnp.einsum("rbhncd,rbhnsd->rbhncs", k_beta, k) * decay_strict
    unit_lower = l_mat + jnp.eye(CHUNK, dtype=l_mat.dtype)
    rhs = jnp.concatenate([v_beta, k_beta * jnp.exp(g_cum)[..., None]], axis=-1)
    sol = lax.linalg.triangular_solve(unit_lower, rhs, left_side=True, lower=True, unit_diagonal=True)
    value, k_cumdecay = sol[..., :dv], sol[..., dv:]

    attn = jnp.einsum("rbhncd,rbhnsd->rbhncs", q, k) * decay_incl
    q_decay = q * jnp.exp(g_cum)[..., None]
    g_last = g_cum[..., -1]
    k_tail = k * jnp.exp(g_last[..., None] - g_cum)[..., None]
    chunk_decay = jnp.exp(g_last)

    def to_front(t):
        return jnp.moveaxis(t, 3, 0)

    def step(S, inp):
        val, kcd, qd, at, kt, cd = inp
        v_new = val - jnp.einsum("rbhcd,rbhde->rbhce", kcd, S)
        o = jnp.einsum("rbhcd,rbhde->rbhce", qd, S) + jnp.einsum("rbhcs,rbhse->rbhce", at, v_new)
        S = S * cd[..., None, None] + jnp.einsum("rbhcd,rbhce->rbhde", kt, v_new)
        return S, o

    S0 = jnp.zeros((R, Bn, H, dk, dv), jnp.float32)
    xs = (to_front(value), to_front(k_cumdecay), to_front(q_decay), to_front(attn),
          to_front(k_tail), to_front(chunk_decay))
    _, o = lax.scan(step, S0, xs)
    return jnp.moveaxis(o, 0, 3).reshape(R, Bn, H, Lp, dv)


def gated_delta_branch(qkv, beta_logits, decay_logits, z, conv_w, a_log, dt_bias, norm_g):
    f32 = jnp.float32
    Bn, L, _ = qkv.shape
    qkv = short_conv(qkv.astype(f32), conv_w.astype(f32))
    q, k, v = jnp.split(qkv, 3, axis=-1)

    def heads(t):
        return t.reshape(Bn, L, N_DELTA_HEADS, HEAD_DIM)

    q = l2norm(heads(q)) * HEAD_DIM ** -0.5
    k = l2norm(heads(k))
    v = heads(v)
    beta = jax.nn.sigmoid(beta_logits.astype(f32)).reshape(Bn, L, N_DIRS, N_DELTA_HEADS)
    g = -jnp.exp(a_log.astype(f32)) * jax.nn.softplus(
        decay_logits.astype(f32).reshape(Bn, L, N_DIRS, N_DELTA_HEADS) + dt_bias.astype(f32))

    pad = ((0, 0), (META_PAD, 0), (0, 0), (0, 0))
    q, k, v, beta, g = [jnp.pad(t, pad) for t in (q, k, v, beta, g)]

    def both_dirs(t):
        t = t.transpose(0, 2, 1, 3)
        return jnp.stack([t, jnp.flip(t, 2)])

    def per_dir(t):
        t = t.transpose(2, 0, 3, 1)
        return jnp.stack([t[0], jnp.flip(t[1], -1)])

    o = chunked_gated_delta_rule(both_dirs(q), both_dirs(k), both_dirs(v), per_dir(beta), per_dir(g))
    o = o[0] + jnp.flip(o[1], 2)
    o = o[:, :, META_PAD:].transpose(0, 2, 1, 3)
    zh = z.astype(f32).reshape(Bn, L, N_DELTA_HEADS, HEAD_DIM)
    o = o * lax.rsqrt(jnp.mean(jnp.square(o), -1, keepdims=True) + RMS_EPS) * norm_g.astype(f32) * jax.nn.silu(zh)
    return o.reshape(Bn, L, DELTA_WIDTH).astype(z.dtype)


def hybrid_layer(x, w_in, conv_w, a_log, dt_bias, delta_norm_g, w_fourier_proj, w_delta_proj, w_out,
                 ln1_g, ln1_b, w_up, w_down, ln2_g, ln2_b):
    proj = jnp.einsum("bld,de->ble", x, w_in)
    cuts = np.cumsum(IN_SPLITS)[:-1].tolist()
    u_f, qkv, beta_l, decay_l, z, gates = jnp.split(proj, cuts, axis=-1)
    y_a = jnp.einsum("blf,fd->bld", fourier_mix(u_f), w_fourier_proj)
    y_b = jnp.einsum("blf,fd->bld",
                     gated_delta_branch(qkv, beta_l, decay_l, z, conv_w, a_log, dt_bias, delta_norm_g),
                     w_delta_proj)
    gate_a, gate_b = jnp.split(jax.nn.sigmoid(gates), 2, axis=-1)
    mix = jnp.einsum("bld,de->ble", gate_a * y_a + gate_b * y_b, w_out)
    x = layer_norm(DEEPNORM_ALPHA * x + mix, ln1_g, ln1_b)
    ff = jnp.einsum("blf,fd->bld", jnp.square(jax.nn.relu(jnp.einsum("bld,df->blf", x, w_up))), w_down)
    return layer_norm(DEEPNORM_ALPHA * x + ff, ln2_g, ln2_b)


def setup_inputs(seed: int = 0) -> dict:
    key = jax.random.key(seed)
    ks = jax.random.split(key, 20)
    f32 = jnp.float32

    def nrm(k, shape, scale):
        return jax.random.normal(k, shape, f32) * scale

    x = nrm(ks[0], (BATCH, SEQ, D_MODEL), 1.0)
    meta_tokens = nrm(ks[1], (N_META, D_MODEL), 1.0)
    ln0_g = 1.0 + nrm(ks[2], (D_MODEL,), 0.02)
    ln0_b = nrm(ks[3], (D_MODEL,), 0.02)
    w_in = nrm(ks[4], (DEPTH, D_MODEL, IN_WIDTH), D_MODEL ** -0.5)
    conv_w = nrm(ks[5], (DEPTH, CONV_WIDTH, QKV_WIDTH), CONV_WIDTH ** -0.5)
    a_log = jnp.log(jax.random.uniform(ks[6], (DEPTH, N_DIRS, N_DELTA_HEADS), f32, 1.0, 16.0))
    dt = jnp.exp(jax.random.uniform(ks[7], (DEPTH, N_DIRS, N_DELTA_HEADS), f32,
                                    float(np.log(1e-3)), float(np.log(1e-1))))
    dt_bias = dt + jnp.log(-jnp.expm1(-dt))
    delta_norm_g = 1.0 + nrm(ks[8], (DEPTH, HEAD_DIM), 0.02)
    w_fourier_proj = nrm(ks[9], (DEPTH, FOURIER_WIDTH, D_MODEL), FOURIER_WIDTH ** -0.5 * DEEPNORM_BETA)
    w_delta_proj = nrm(ks[10], (DEPTH, DELTA_WIDTH, D_MODEL), DELTA_WIDTH ** -0.5 * DEEPNORM_BETA)
    w_out = nrm(ks[11], (DEPTH, D_MODEL, D_MODEL), D_MODEL ** -0.5 * DEEPNORM_BETA)
    ln1_g = 1.0 + nrm(ks[12], (DEPTH, D_MODEL), 0.02)
    ln1_b = nrm(ks[13], (DEPTH, D_MODEL), 0.02)
    w_up = nrm(ks[14], (DEPTH, D_MODEL, D_FF), D_MODEL ** -0.5)
    w_down = nrm(ks[15], (DEPTH, D_FF, D_MODEL), D_FF ** -0.5 * DEEPNORM_BETA)
    ln2_g = 1.0 + nrm(ks[16], (DEPTH, D_MODEL), 0.02)
    ln2_b = nrm(ks[17], (DEPTH, D_MODEL), 0.02)
    return {"x": x, "meta_tokens": meta_tokens, "ln0_g": ln0_g, "ln0_b": ln0_b, "w_in": w_in,
            "conv_w": conv_w, "a_log": a_log, "dt_bias": dt_bias, "delta_norm_g": delta_norm_g,
            "w_fourier_proj": w_fourier_proj, "w_delta_proj": w_delta_proj, "w_out": w_out,
            "ln1_g": ln1_g, "ln1_b": ln1_b, "w_up": w_up, "w_down": w_down,
            "ln2_g": ln2_g, "ln2_b": ln2_b}


def reference(x, meta_tokens, ln0_g, ln0_b, w_in, conv_w, a_log, dt_bias, delta_norm_g,
              w_fourier_proj, w_delta_proj, w_out, ln1_g, ln1_b, w_up, w_down, ln2_g, ln2_b):
    Bn = x.shape[0]
    meta = jnp.broadcast_to(meta_tokens[None].astype(x.dtype), (Bn, N_META, x.shape[-1]))
    h = layer_norm(jnp.concatenate([meta, x], axis=1), ln0_g, ln0_b)
    for l in range(DEPTH):
        h = hybrid_layer(h, w_in[l], conv_w[l], a_log[l], dt_bias[l], delta_norm_g[l],
                         w_fourier_proj[l], w_delta_proj[l], w_out[l],
                         ln1_g[l], ln1_b[l], w_up[l], w_down[l], ln2_g[l], ln2_b[l])
    return h[:, N_META:]
```

```cpp
#include <hip/hip_runtime.h>
#include <hip/hip_cooperative_groups.h>
#include <cstdio>
#include <cstdint>
namespace cg = cooperative_groups;

#define LAS __attribute__((address_space(3)))
typedef unsigned short bf16;
typedef short bf16x8 __attribute__((ext_vector_type(8)));
typedef float f32x4 __attribute__((ext_vector_type(4)));
typedef unsigned u32x4 __attribute__((ext_vector_type(4)));
typedef unsigned u32x2 __attribute__((ext_vector_type(2)));

constexpr int DM = 1024, NBATCH = 8, SEQ = 4096, NMETA = 16, LTOK = 4112, LPAD = 4160, NROWS = NBATCH * LPAD  , PADR = 48;
constexpr int HALF_L = 2056;
constexpr int NMAIN = NBATCH * SEQ;
__device__ __forceinline__ int row_of(int b, int pp) { return pp >= 64 ? b * SEQ + (pp - 64) : NMAIN + b * 64 + pp; }
__device__ __forceinline__ void pos_of(int r, int& b, int& pp) { if (r < NMAIN) { b = r >> 12; pp = 64 + (r & 4095); } else { const int q = r - NMAIN; b = q >> 6; pp = q & 63; } }
constexpr int DFT_M = 1280, DFT_K = 1152, DFT_NC = 2304, DFT_NS = 2048;
constexpr int N1 = 2816, N2 = 2048, NIN = 4864, DFF = 4096, INW = 4624;
constexpr int NSEG = 4;
constexpr int SLOT_A = 0, SLOT_Q = 32768, SLOT_N = 49152, SLOT_O = 81920, SLOT_CD = 98304, SLOT = 98560;
constexpr float ALPHA = 1.41421356237f;

constexpr size_t MiB = 1048576;
constexpr size_t WS_WIN = 0, WS_WUP = 19 * MiB, WS_WDN = 35 * MiB, WS_WOUT = 51 * MiB, WS_WFP = 55 * MiB, WS_WDP = 57 * MiB, WS_CM = 59 * MiB, WS_SM = 69 * MiB;
constexpr size_t WS_XB = 80 * MiB, WS_H = 145 * MiB, WS_UF = 145 * MiB, WS_QKV = 178 * MiB, WS_TMP = 178 * MiB, WS_Z = 276 * MiB, WS_OF = 309 * MiB, WS_OB = 342 * MiB;
constexpr size_t WS_BD = 375 * MiB, WS_ECT = 309 * MiB, WS_EST = 320 * MiB, WS_P = 329 * MiB, WS_Q = 352 * MiB,     WS_DS = 378 * MiB, WS_G = 378 * MiB, WS_SST = 482 * MiB, WS_DSX = 475 * MiB, WS_TOUT = 300 * MiB, WS_TDN = 410 * MiB;
constexpr size_t WS_BAR = 508 * MiB;
constexpr size_t WS_END = 509 * MiB;
constexpr int LDS_BYTES = 147456;

struct Params {
    const float *x, *meta, *ln0g, *ln0b, *w_in, *conv_w, *a_log, *dt_bias, *dng, *w_fp, *w_dp, *w_out, *ln1g, *ln1b, *w_up, *w_down, *ln2g, *ln2b;
    float* out; unsigned char* ws; int ph_lo, ph_hi;
};

__device__ __forceinline__ int opaque_tid() { int t = threadIdx.x; asm volatile("" : "+v"(t)); return t; }
template <class T> __device__ __forceinline__ T* opaque_ptr(T* q) { asm volatile("" : "+s"(q)); return q; }
__device__ __forceinline__ void lds_barrier() { asm volatile("s_waitcnt lgkmcnt(0)" ::: "memory"); __builtin_amdgcn_s_barrier(); asm volatile("" ::: "memory"); }
__device__ __forceinline__ float bf2f(unsigned short h) { return __uint_as_float(((unsigned)h) << 16); }
typedef float f32x2c __attribute__((ext_vector_type(2)));
typedef __bf16 bf16x2c __attribute__((ext_vector_type(2)));
__device__ __forceinline__ unsigned pack2(float lo, float hi) { const f32x2c v = {lo, hi}; const bf16x2c r = __builtin_convertvector(v, bf16x2c); return __builtin_bit_cast(unsigned, r); }
__device__ __forceinline__ unsigned short f2bf(float f) { return (unsigned short)(pack2(f, 0.f) & 0xffffu); }
__device__ __forceinline__ float wave_sum(float v) {
#pragma unroll
    for (int o = 32; o; o >>= 1) v += __shfl_xor(v, o);
    return v;
}
__device__ __forceinline__ float sigmoidf_(float x) { return __builtin_amdgcn_rcpf(1.0f + __expf(-x)); }
#define XB_TMO      128
#define XB_XCNT(j)  (256  + 64 * (j))
#define XB_XSUB(j)  (1280 + 64 * (j))
#define XB_XGEN(j)  (2304 + 64 * (j))
#define XB_TOP      3328
#define XB_TOPGEN   3392
#define XCD_BAR_WORDS 3456
#define XB_SPIN_CAP (1u << 18)

__device__ __forceinline__ unsigned xb_ld(unsigned* p)              { return __hip_atomic_load(p, __ATOMIC_RELAXED, __HIP_MEMORY_SCOPE_AGENT); }
__device__ __forceinline__ unsigned xb_add(unsigned* p, unsigned v) { return __hip_atomic_fetch_add(p, v, __ATOMIC_RELAXED, __HIP_MEMORY_SCOPE_AGENT); }
__device__ __forceinline__ unsigned xb_xcc_id() { return (unsigned)__builtin_amdgcn_s_getreg((3 << 11) | 20) & 0xFu; }
#define XB_SPIN(cond, bar) do { unsigned _sp = 0; while (cond) { __builtin_amdgcn_s_sleep(1); \
    if ((++_sp & 255u) == 0u) { if (xb_ld(&(bar)[XB_TMO])) break; if (_sp > XB_SPIN_CAP) { atomicAdd(&(bar)[XB_TMO], 1u); break; } } } } while (0)

struct XcdBarrier {
    unsigned* bar; unsigned x;
    volatile LAS unsigned* st;
};

__device__ __forceinline__ XcdBarrier xcd_barrier_post(unsigned* bar, volatile LAS unsigned* st) {
    XcdBarrier b; b.bar = bar; b.x = xb_xcc_id(); b.st = st;
    if (threadIdx.x == 0) (void)xb_add(&bar[XB_XCNT(b.x)], 1u);
    return b;
}
__device__ __forceinline__ void xcd_barrier_complete(unsigned* bar, unsigned x, unsigned& nloc, unsigned& nx) {
    const unsigned G = gridDim.x * gridDim.y * gridDim.z;
    unsigned sum, cnt, mine, sp = 0u;
    for (;;) {
        sum = 0u; cnt = 0u; mine = 0u;
#pragma unroll
        for (unsigned j = 0; j < 16; ++j) { const unsigned c = xb_ld(&bar[XB_XCNT(j)]); sum += c; cnt += (c > 0u) ? 1u : 0u; mine = (j == x) ? c : mine; }
        if (sum == G) break;
        __builtin_amdgcn_s_sleep(1);
        if ((++sp & 255u) == 0u) { if (xb_ld(&bar[XB_TMO])) break; if (sp > XB_SPIN_CAP) { atomicAdd(&bar[XB_TMO], 1u); break; } }
    }
    nloc = mine > 0u ? mine : 1u; nx = cnt > 0u ? cnt : 1u;
}

__device__ __forceinline__ void xcd_barrier(const XcdBarrier& b) {
    asm volatile("s_waitcnt vmcnt(0)" ::: "memory");
    __syncthreads();
    if (threadIdx.x == 0) {
        unsigned* bar = b.bar;
        __builtin_amdgcn_s_waitcnt(0);
        unsigned nloc = b.st[0], nx = b.st[1];
        if (nloc == 0u) { xcd_barrier_complete(bar, b.x, nloc, nx); b.st[0] = nloc; b.st[1] = nx; }
        const unsigned old = xb_add(&bar[XB_XSUB(b.x)], 1u);
        const unsigned gen = old / nloc;
        if (old + 1u == (gen + 1u) * nloc) {
            __builtin_amdgcn_fence(__ATOMIC_RELEASE, "agent");
            asm volatile("s_waitcnt vmcnt(0)" ::: "memory");
            const unsigned og = xb_add(&bar[XB_TOP], 1u);
            const unsigned tg = og / nx;
            if (og + 1u == (tg + 1u) * nx) xb_add(&bar[XB_TOPGEN], 1u);
            else XB_SPIN(xb_ld(&bar[XB_TOPGEN]) == tg, bar);
            __builtin_amdgcn_fence(__ATOMIC_ACQUIRE, "agent");
            xb_add(&bar[XB_XGEN(b.x)], 1u);
            asm volatile("s_waitcnt vmcnt(0)" ::: "memory");
        } else {
            XB_SPIN(xb_ld(&bar[XB_XGEN(b.x)]) == gen, bar);
            __builtin_amdgcn_fence(__ATOMIC_ACQUIRE, "agent");
            asm volatile("s_waitcnt vmcnt(0)" ::: "memory");
        }
    }
    __syncthreads();
}

namespace pg8 {
#define PG8_LAS __attribute__((address_space(3)))
typedef unsigned short bf16_t;
typedef short bf16x8 __attribute__((ext_vector_type(8)));
typedef float f32x4 __attribute__((ext_vector_type(4)));
typedef unsigned u32x4 __attribute__((ext_vector_type(4)));
constexpr int BM = 256, BK = 64, HALF = 128, HTB = HALF * BK * 2  , STAGE_BYTES = 8 * HTB, NXCD = 8, WGM = 8;

__host__ __device__ __forceinline__ int lds_byte(int r, int c) { const int st = (r >> 4) * 2 + (c >> 5), rr = r & 15, cc = c & 31, ob = rr * 64 + cc * 2; return st * 1024 + (ob ^ (((ob >> 9) & 1) << 5)); }
__host__ __device__ __forceinline__ void stage_rc(int b, int& R, int& C) { const int st = b / 1024, sb = b % 1024, swz = sb ^ (((sb >> 9) & 1) << 5); R = (st >> 1) * 16 + swz / 64; C = (st & 1) * 32 + (swz % 64) / 2; }
__host__ __device__ __forceinline__ int perm32(int rho) { const int n = rho >> 4, i = rho & 15; return 8 * (i >> 2) + 4 * n + (i & 3); }

struct Unit { int pm, pn, koff, kp; };
struct Gemm { const bf16_t* A; const bf16_t* Bt; int M, N, K, ld; };

struct StaticOrder {
    int nM, nN, nwg, G, c;
    __host__ __device__ void init(int M, int N, int G_, int c_) { nM = M / BM; nN = N / BM; nwg = nM * nN; G = G_; c = c_; }
    __host__ __device__ bool next(int i, Unit& u) const {
        const long L = (long)i * G + c; if (L >= nwg) return false;
        int wgid = (int)L; { const int q = nwg / NXCD, r = nwg % NXCD, xcd = wgid % NXCD, off = wgid / NXCD; wgid = (xcd < r ? xcd * (q + 1) : r * (q + 1) + (xcd - r) * q) + off; }
        const int nig = WGM * nN, gid = wgid / nig, fm = gid * WGM, gsz = (nM - fm) < WGM ? (nM - fm) : WGM;
        u.pm = fm + ((wgid % nig) % gsz); u.pn = (wgid % nig) / gsz; u.koff = 0; u.kp = 0; return true;
    }
    __device__ __forceinline__ void a_ready(const Unit&) const {}
    __device__ __forceinline__ void done(const Unit&) const {}
};
__device__ __forceinline__ unsigned cvt_pk_bf16(float lo, float hi) { return ::pack2(lo, hi); }
__device__ __forceinline__ u32x4 pack8(f32x4 v0, f32x4 v1) { u32x4 w; w.x = cvt_pk_bf16(v0[0], v0[1]); w.y = cvt_pk_bf16(v0[2], v0[3]); w.z = cvt_pk_bf16(v1[0], v1[1]); w.w = cvt_pk_bf16(v1[2], v1[3]); return w; }
__device__ __forceinline__ void unpack8(u32x4 w, f32x4& v0, f32x4& v1) {
    v0[0] = __uint_as_float(w.x << 16); v0[1] = __uint_as_float(w.x & 0xffff0000u); v0[2] = __uint_as_float(w.y << 16); v0[3] = __uint_as_float(w.y & 0xffff0000u);
    v1[0] = __uint_as_float(w.z << 16); v1[1] = __uint_as_float(w.z & 0xffff0000u); v1[2] = __uint_as_float(w.w << 16); v1[3] = __uint_as_float(w.w & 0xffff0000u);
}
__device__ __forceinline__ float sigm(float x) { return __builtin_amdgcn_rcpf(1.0f + __expf(-x)); }
enum { EP_PROJ1 = 0, EP_SIGM = 1, EP_F32 = 2, EP_MERGE0 = 3, EP_MERGE1 = 4, EP_RES = 5, EP_SQRELU = 6, EP_PART = 7 };
struct Epi {
    static constexpr bool PERM = true, AFTER_DRAIN = false;
    int mode; int ldc; int goff; bf16_t* o; float* of32; const bf16_t* gate; bf16_t* uf; bf16_t* qkv; bf16_t* z; float* bd;
    __device__ __forceinline__ void operator()(const f32x4 (&acc)[2][2][4][2], const Unit& u, int wr, int wc, int fr, int fq) const {
        const int row0 = u.pm * BM + wr * 64 + fr, cl = wc * 32 + 8 * fq;
        if (mode == EP_RES) {
#pragma unroll
            for (int ai = 0; ai < 2; ++ai) {
                u32x4 l0[4][2];
#pragma unroll
                for (int m = 0; m < 4; ++m)
#pragma unroll
                    for (int bj = 0; bj < 2; ++bj) l0[m][bj] = *(const u32x4*)(o + (size_t)(row0 + ai * HALF + m * 16) * ldc + u.pn * BM + bj * HALF + cl);
#pragma unroll
                for (int m = 0; m < 4; ++m)
#pragma unroll
                    for (int bj = 0; bj < 2; ++bj) {
                        f32x4 v0 = acc[ai][bj][m][0], v1 = acc[ai][bj][m][1], p0, p1; unpack8(l0[m][bj], p0, p1);
                        v0 = v0 + p0 * 1.41421356237f; v1 = v1 + p1 * 1.41421356237f;
                        *(u32x4*)(o + (size_t)(row0 + ai * HALF + m * 16) * ldc + u.pn * BM + bj * HALF + cl) = pack8(v0, v1);
                    }
            }
            return;
        }
        if (mode == EP_MERGE0) {
#pragma unroll
            for (int ai = 0; ai < 2; ++ai) {
                u32x4 l0[4][2];
#pragma unroll
                for (int m = 0; m < 4; ++m)
#pragma unroll
                    for (int bj = 0; bj < 2; ++bj) l0[m][bj] = *(const u32x4*)(gate + (size_t)(row0 + ai * HALF + m * 16) * 2048 + u.pn * BM + bj * HALF + cl);
#pragma unroll
                for (int m = 0; m < 4; ++m)
#pragma unroll
                    for (int bj = 0; bj < 2; ++bj) {
                        f32x4 v0 = acc[ai][bj][m][0], v1 = acc[ai][bj][m][1], p0, p1; unpack8(l0[m][bj], p0, p1);
                        *(u32x4*)(o + (size_t)(row0 + ai * HALF + m * 16) * ldc + u.pn * BM + bj * HALF + cl) = pack8(v0 * p0, v1 * p1);
                    }
            }
            return;
        }
        if (mode == EP_MERGE1) {
#pragma unroll
            for (int ai = 0; ai < 2; ++ai)
#pragma unroll
                for (int mh = 0; mh < 2; ++mh) {
                    u32x4 l0[2][2], l1[2][2];
#pragma unroll
                    for (int m2 = 0; m2 < 2; ++m2)
#pragma unroll
                        for (int bj = 0; bj < 2; ++bj) {
                            const size_t row = (size_t)(row0 + ai * HALF + (mh * 2 + m2) * 16); const int col = u.pn * BM + bj * HALF + cl;
                            l0[m2][bj] = *(const u32x4*)(gate + row * 2048 + col);
                            l1[m2][bj] = (u32x4){0u, 0u, 0u, 0u};
                            if (mode == EP_MERGE1) l1[m2][bj] = *(const u32x4*)(o + row * ldc + col);
                        }
#pragma unroll
                    for (int m2 = 0; m2 < 2; ++m2)
#pragma unroll
                        for (int bj = 0; bj < 2; ++bj) {
                            const int m = mh * 2 + m2;
                            const size_t row = (size_t)(row0 + ai * HALF + m * 16); const int col = u.pn * BM + bj * HALF + cl;
                            f32x4 v0 = acc[ai][bj][m][0], v1 = acc[ai][bj][m][1], p0, p1, q0, q1; unpack8(l0[m2][bj], p0, p1); unpack8(l1[m2][bj], q0, q1);
                            v0 = v0 * p0 + q0; v1 = v1 * p1 + q1;
                            *(u32x4*)(o + row * ldc + col) = pack8(v0, v1);
                        }
                }
            return;
        }
#pragma unroll
        for (int ai = 0; ai < 2; ++ai)
#pragma unroll
            for (int m = 0; m < 4; ++m) {
                const size_t row = (size_t)(row0 + ai * HALF + m * 16);
#pragma unroll
                for (int bj = 0; bj < 2; ++bj) {
                    const int col = u.pn * BM + bj * HALF + cl;
                    f32x4 v0 = acc[ai][bj][m][0], v1 = acc[ai][bj][m][1];
                    if (mode == EP_PROJ1) {
                        if (u.pn < 2) { *(u32x4*)(uf + row * 512 + col) = pack8(v0, v1); }
                        else if (u.pn < 8) { *(u32x4*)(qkv + row * 1536 + (col - 512)) = pack8(v0, v1); }
                        else if (u.pn < 10) {
#pragma unroll
                            for (int e = 0; e < 4; ++e) { v0[e] = v0[e] * sigm(v0[e]); v1[e] = v1[e] * sigm(v1[e]); }
                            *(u32x4*)(z + row * 512 + (col - 2048)) = pack8(v0, v1);
                        } else { if (bj == 0 && wc == 0 && fq < 2) { float* d = bd + row * 16 + 8 * fq; *(f32x4*)d = v0; *(f32x4*)(d + 4) = v1; } }
                    } else if (mode == EP_SIGM) {
#pragma unroll
                        for (int e = 0; e < 4; ++e) { v0[e] = sigm(v0[e]); v1[e] = sigm(v1[e]); }
                        *(u32x4*)(o + row * ldc + col) = pack8(v0, v1);
                    } else if (mode == EP_F32) {
                        float* d = of32 + row * ldc + col; *(f32x4*)d = v0; *(f32x4*)(d + 4) = v1;
                    } else if (mode == EP_PART) {
                        float* d = of32 + ((size_t)u.kp * 512 + (row - (size_t)goff)) * 1024 + col; *(f32x4*)d = v0; *(f32x4*)(d + 4) = v1;
                    } else {
#pragma unroll
                        for (int e = 0; e < 4; ++e) { float a = v0[e] > 0.f ? v0[e] : 0.f, b = v1[e] > 0.f ? v1[e] : 0.f; v0[e] = a * a; v1[e] = b * b; }
                        *(u32x4*)(o + row * ldc + col) = pack8(v0, v1);
                    }
                }
            }
    }
};
struct Order {
    int nM, nN, nwg, G, c, swz, ks, kbytes, pm0;
    __device__ void init(int M, int N, int G_, int c_, int swz_) { nM = M / BM; nN = N / BM; nwg = nM * nN; G = G_; c = c_; swz = swz_; ks = 1; kbytes = 0; pm0 = 0; }
    __device__ void init_split(int ntile, int pm0_, int N, int ks_, int kbytes_, int G_, int c_) { nM = ntile; nN = N / BM; ks = ks_; kbytes = kbytes_; pm0 = pm0_; nwg = nM * nN * ks; G = G_; c = c_; swz = 2; }
    __device__ bool next(int i, Unit& u) const {
        const long L = (long)i * G + c; if (L >= nwg) return false;
        u.koff = 0; u.kp = 0;
        if (swz == 2) { const int l = (int)L; u.kp = l % ks; u.koff = u.kp * kbytes; const int r = l / ks; u.pn = r % nN; u.pm = pm0 + r / nN; return true; }
        if (!swz) { u.pm = (int)L % nM; u.pn = (int)L / nM; return true; }
        int wgid = (int)L; { const int q = nwg / NXCD, r = nwg % NXCD, xcd = wgid % NXCD, off = wgid / NXCD; wgid = (xcd < r ? xcd * (q + 1) : r * (q + 1) + (xcd - r) * q) + off; }
        const int nig = WGM * nN, gid = wgid / nig, fm = gid * WGM, gsz = (nM - fm) < WGM ? (nM - fm) : WGM;
        u.pm = fm + ((wgid % nig) % gsz); u.pn = (wgid % nig) / gsz; return true;
    }
    __device__ __forceinline__ void a_ready(const Unit&) const {}
    __device__ __forceinline__ void done(const Unit&) const {}
};
template <class Epi, class Sched, bool ALIGN_EPI = false, bool SP2 = false>
__device__ __forceinline__ void gemm_phase(PG8_LAS unsigned char* lds, const Gemm g, const Sched& S, const Epi& E) {
    const int tid = opaque_tid(), wid = __builtin_amdgcn_readfirstlane(tid >> 6), lane = tid & 63, wr = wid >> 2, wc = wid & 3, fr = lane & 15, fq = lane >> 4;
    const int K = g.K, nt = K / BK, LD = g.ld;
    unsigned voffA[2], voffB[2];
#pragma unroll
    for (int i = 0; i < 2; ++i) { int R, C; stage_rc(tid * 16 + i * 8192, R, C); const int Rb = Epi::PERM ? ((R & ~31) + perm32(R & 31)) : R;
        voffA[i] = (unsigned)(R * LD + C) * 2u; voffB[i] = (unsigned)(Rb * LD + C) * 2u; }
    const size_t kstep = (size_t)(BK * 2);
    const size_t hstep = (size_t)HALF * LD * 2;
    const size_t tstep = 2 * hstep;
    const unsigned ldsw = (unsigned)wid * 1024u;
    const int aoff = lds_byte(wr * 64 + fr, fq * 8), boff = lds_byte(wc * 32 + fr, fq * 8);
#define PG8_SA(b, h) (((b) * 2 + (h)) * HTB)
#define PG8_SB(b, h) ((4 + (b) * 2 + (h)) * HTB)
#define PG8_STAGE(bufoff, gbase, voff) do { _Pragma("unroll") for (int _i = 0; _i < 2; ++_i) \
        __builtin_amdgcn_global_load_lds((const unsigned*)((const char*)(gbase) + (voff)[_i]), (PG8_LAS unsigned*)(lds + (bufoff) + ldsw + _i * 8192), 16, 0, 0); } while (0)
#define PG8_LDA(dst, b, h) do { _Pragma("unroll") for (int m = 0; m < 4; ++m) _Pragma("unroll") for (int k = 0; k < 2; ++k) dst[m][k] = *(const PG8_LAS bf16x8*)(lds + PG8_SA(b, h) + aoff + m * 2048 + k * 1024); } while (0)
#define PG8_LDB(dst, b, h) do { _Pragma("unroll") for (int n = 0; n < 2; ++n) _Pragma("unroll") for (int k = 0; k < 2; ++k) dst[n][k] = *(const PG8_LAS bf16x8*)(lds + PG8_SB(b, h) + boff + n * 2048 + k * 1024); } while (0)
#define PG8_MMA(ai, bj, At, Bt) do { __builtin_amdgcn_s_setprio(1); _Pragma("unroll") for (int m = 0; m < 4; ++m) _Pragma("unroll") for (int n = 0; n < 2; ++n) _Pragma("unroll") for (int k = 0; k < 2; ++k) \
        acc[ai][bj][m][n] = __builtin_amdgcn_mfma_f32_16x16x32_bf16(Bt[n][k], At[m][k], acc[ai][bj][m][n], 0, 0, 0); __builtin_amdgcn_s_setprio(0); } while (0)
#define PG8_WAIT_V(n) asm volatile("s_waitcnt vmcnt(" #n ")" ::: "memory")
#define PG8_WAIT_L(n) asm volatile("s_waitcnt lgkmcnt(" #n ")" ::: "memory")
#define PG8_BAR __builtin_amdgcn_s_barrier()
#define PG8_SCHED __builtin_amdgcn_sched_barrier(0)
    Unit cur, nxt; int ui = 0;
    if (!S.next(0, cur)) return;
    f32x4 acc[2][2][4][2];
#pragma unroll
    for (int a = 0; a < 2; ++a)
#pragma unroll
        for (int b = 0; b < 2; ++b)
#pragma unroll
            for (int m = 0; m < 4; ++m)
#pragma unroll
                for (int n = 0; n < 2; ++n) acc[a][b][m][n] = (f32x4){0.f, 0.f, 0.f, 0.f};
    bf16x8 At[4][2], B0[2][2], B1[2][2];
    const char* cA = (const char*)g.A + (size_t)cur.pm * tstep + cur.koff; const char* cB = (const char*)g.Bt + (size_t)cur.pn * tstep + cur.koff;
    S.a_ready(cur);
    if constexpr (SP2) {
        PG8_STAGE(PG8_SB(0, 0), cB, voffB); PG8_STAGE(PG8_SB(0, 1), cB + hstep, voffB); PG8_STAGE(PG8_SA(0, 0), cA, voffA); PG8_STAGE(PG8_SA(0, 1), cA + hstep, voffA);
        if (wr == 1) PG8_BAR;
        PG8_WAIT_V(2); PG8_BAR;
        PG8_STAGE(PG8_SB(1, 0), cB + kstep, voffB); PG8_STAGE(PG8_SA(1, 0), cA + kstep, voffA); PG8_STAGE(PG8_SB(1, 1), cB + hstep + kstep, voffB);
        PG8_WAIT_V(6); PG8_BAR;
    } else {
        PG8_STAGE(PG8_SB(0, 0), cB, voffB); PG8_STAGE(PG8_SA(0, 0), cA, voffA); PG8_STAGE(PG8_SB(0, 1), cB + hstep, voffB); PG8_STAGE(PG8_SA(0, 1), cA + hstep, voffA);
        if (wr == 1) PG8_BAR;
        PG8_WAIT_V(4); PG8_BAR;
        PG8_STAGE(PG8_SB(1, 0), cB + kstep, voffB); PG8_STAGE(PG8_SA(1, 0), cA + kstep, voffA); PG8_STAGE(PG8_SB(1, 1), cB + hstep + kstep, voffB);
        PG8_WAIT_V(6); PG8_BAR;
    }
    for (;;) {
        const bool has_next = S.next(ui + 1, nxt);
        const char* nA = has_next ? (const char*)g.A + (size_t)nxt.pm * tstep + nxt.koff : cA; const char* nB = has_next ? (const char*)g.Bt + (size_t)nxt.pn * tstep + nxt.koff : cB;
        for (int t = 0; t < nt; t += 2) {
            const bool last = (t == nt - 2);
            const char* a1 = cA + (size_t)(t + 1) * kstep;
            const char* a2 = last ? nA : cA + (size_t)(t + 2) * kstep; const char* b2 = last ? nB : cB + (size_t)(t + 2) * kstep;
            const char* a3 = a2 + kstep; const char* b3 = b2 + kstep;
            if (last && has_next) S.a_ready(nxt);
            if constexpr (SP2) {
            PG8_LDB(B0, 0, 0); PG8_LDB(B1, 0, 1); PG8_SCHED; PG8_LDA(At, 0, 0); PG8_STAGE(PG8_SA(1, 1), a1 + hstep, voffA);
            PG8_WAIT_V(8); PG8_WAIT_L(0); PG8_BAR; PG8_MMA(0, 0, At, B0); PG8_MMA(0, 1, At, B1); PG8_BAR; PG8_SCHED;
            PG8_LDA(At, 0, 1); PG8_STAGE(PG8_SB(0, 0), b2, voffB); PG8_STAGE(PG8_SB(0, 1), b2 + hstep, voffB); PG8_STAGE(PG8_SA(0, 0), a2, voffA);
            PG8_WAIT_V(8); PG8_WAIT_L(0); PG8_BAR; PG8_MMA(1, 0, At, B0); PG8_MMA(1, 1, At, B1); PG8_BAR; PG8_SCHED;
            PG8_LDB(B0, 1, 0); PG8_LDB(B1, 1, 1); PG8_SCHED; PG8_LDA(At, 1, 0); PG8_STAGE(PG8_SA(0, 1), a2 + hstep, voffA);
            PG8_WAIT_V(8); PG8_WAIT_L(0); PG8_BAR; PG8_MMA(0, 0, At, B0); PG8_MMA(0, 1, At, B1); PG8_BAR; PG8_SCHED;
            PG8_LDA(At, 1, 1); PG8_STAGE(PG8_SB(1, 0), b3, voffB); PG8_STAGE(PG8_SB(1, 1), b3 + hstep, voffB); PG8_STAGE(PG8_SA(1, 0), a3, voffA);
            PG8_WAIT_V(8); PG8_WAIT_L(0); PG8_BAR; PG8_MMA(1, 0, At, B0); PG8_MMA(1, 1, At, B1); PG8_BAR; PG8_SCHED;
            } else {
            PG8_LDB(B0, 0, 0); PG8_SCHED; PG8_LDA(At, 0, 0); PG8_STAGE(PG8_SA(1, 1), a1 + hstep, voffA);
            PG8_WAIT_L(8); PG8_BAR; PG8_WAIT_L(0); PG8_MMA(0, 0, At, B0); PG8_BAR; PG8_SCHED;
            PG8_LDB(B1, 0, 1); PG8_STAGE(PG8_SB(0, 0), b2, voffB);
            PG8_BAR; PG8_WAIT_L(0); PG8_MMA(0, 1, At, B1); PG8_BAR;
            PG8_LDA(At, 0, 1); PG8_STAGE(PG8_SA(0, 0), a2, voffA);
            PG8_BAR; PG8_WAIT_L(0); PG8_MMA(1, 0, At, B0); PG8_BAR; PG8_SCHED;
            PG8_STAGE(PG8_SB(0, 1), b2 + hstep, voffB);
            PG8_WAIT_V(6); PG8_BAR; PG8_MMA(1, 1, At, B1); PG8_BAR;
            PG8_LDB(B0, 1, 0); PG8_SCHED; PG8_LDA(At, 1, 0); PG8_STAGE(PG8_SA(0, 1), a2 + hstep, voffA);
            PG8_WAIT_L(8); PG8_BAR; PG8_WAIT_L(0); PG8_MMA(0, 0, At, B0); PG8_BAR; PG8_SCHED;
            PG8_LDB(B1, 1, 1); PG8_STAGE(PG8_SB(1, 0), b3, voffB);
            PG8_BAR; PG8_WAIT_L(0); PG8_MMA(0, 1, At, B1); PG8_BAR;
            PG8_LDA(At, 1, 1); PG8_STAGE(PG8_SA(1, 0), a3, voffA);
            PG8_BAR; PG8_WAIT_L(0); PG8_MMA(1, 0, At, B0); PG8_BAR; PG8_SCHED;
            PG8_STAGE(PG8_SB(1, 1), b3 + hstep, voffB);
            PG8_WAIT_V(6); PG8_BAR; PG8_MMA(1, 1, At, B1); PG8_BAR;
            }
        }
        if constexpr (ALIGN_EPI) { if (wr == 0) PG8_BAR; }
        if constexpr (!Epi::AFTER_DRAIN) { E(acc, cur, wr, wc, fr, fq); S.done(cur); }
        if (!has_next) break;
#pragma unroll
        for (int a = 0; a < 2; ++a)
#pragma unroll
            for (int b = 0; b < 2; ++b)
#pragma unroll
                for (int m = 0; m < 4; ++m)
#pragma unroll
                    for (int n = 0; n < 2; ++n) acc[a][b][m][n] = (f32x4){0.f, 0.f, 0.f, 0.f};
        cur = nxt; cA = nA; cB = nB; ++ui;
        if constexpr (ALIGN_EPI) { if (wr == 1) PG8_BAR; }
    }
    PG8_WAIT_V(0);
    if constexpr (!ALIGN_EPI) { if (wr == 0) PG8_BAR; }
    PG8_BAR;
    if constexpr (Epi::AFTER_DRAIN) { E.fused(acc, cur, wr, wc, fr, fq, lds, wid, lane); S.done(cur); }
#undef PG8_SA
#undef PG8_SB
#undef PG8_STAGE
#undef PG8_LDA
#undef PG8_LDB
#undef PG8_MMA
#undef PG8_WAIT_V
#undef PG8_WAIT_L
#undef PG8_BAR
#undef PG8_SCHED
}
}
#define NT 512
__device__ __forceinline__ bf16x8 lds_frag(const LAS bf16* p) { return *(const LAS bf16x8*)p; }

template <int CTRL> __device__ __forceinline__ float dpp_f(float v) { return __int_as_float(__builtin_amdgcn_update_dpp(0, __float_as_int(v), CTRL, 0xf, 0xf, false)); }
__device__ __forceinline__ float rdlane(float v, int l) { return __int_as_float(__builtin_amdgcn_readlane(__float_as_int(v), l)); }
__device__ __forceinline__ float wave_sum_dpp(float v) {
    v += dpp_f<0x128>(v); v += dpp_f<0x124>(v); v += dpp_f<0x122>(v); v += dpp_f<0x121>(v);
    return (rdlane(v, 0) + rdlane(v, 16)) + (rdlane(v, 32) + rdlane(v, 48));
}

__device__ __forceinline__ int win_src_col(int n) {
    if (n < 2048) return n;
    if (n < 2560) return 2064 + (n - 2048);
    if (n < 2576) return 2048 + (n - 2560);
    if (n < 2816) return -1;
    return 2576 + (n - 2816);
}
__device__ __forceinline__ void transpose_tile(LAS float* tile, const float* src, int ld_src, bf16* dst, int K, int n0, int k0, bool winmap) {
    const int tid = opaque_tid();
    float v[16];
#pragma unroll
    for (int e = 0; e < 16; ++e) {
        const int idx = tid + NT * e, kk = idx >> 6, nn = idx & 63;
        const int col = winmap ? win_src_col(n0 + nn) : (n0 + nn);
        v[e] = col >= 0 ? src[(size_t)(k0 + kk) * ld_src + col] : 0.f;
    }
#pragma unroll
    for (int e = 0; e < 16; ++e) { const int idx = tid + NT * e; tile[(idx >> 6) * 65 + (idx & 63)] = v[e]; }
    __syncthreads();
#pragma unroll
    for (int e = 0; e < 8; ++e) {
        const int idx = tid + NT * e, nn = idx >> 6, kk = (idx & 63) * 2;
        *(unsigned*)(dst + (size_t)(n0 + nn) * K + k0 + kk) = pack2(tile[kk * 65 + nn], tile[(kk + 1) * 65 + nn]);
    }
    __syncthreads();
}
__device__ __forceinline__ void ln_row_store(const float (&v)[16], const float (&g)[16], const float (&b)[16], int lane, bf16* orow, float* frow) {
    float s = 0.f;
#pragma unroll
    for (int e = 0; e < 16; ++e) s += v[e];
    const float mu = wave_sum_dpp(s) * (1.0f / 1024.0f);
    float q = 0.f;
#pragma unroll
    for (int e = 0; e < 16; ++e) { const float d = v[e] - mu; q += d * d; }
    const float rs = rsqrtf(wave_sum_dpp(q) * (1.0f / 1024.0f) + 1e-5f);
#pragma unroll
    for (int hh = 0; hh < 2; ++hh) {
        const int c0 = hh * 512 + 8 * lane;
        float y[8];
#pragma unroll
        for (int e = 0; e < 8; ++e) y[e] = (v[hh * 8 + e] - mu) * rs * g[hh * 8 + e] + b[hh * 8 + e];
        if (orow) { u32x4 w; w.x = pack2(y[0], y[1]); w.y = pack2(y[2], y[3]); w.z = pack2(y[4], y[5]); w.w = pack2(y[6], y[7]); *(u32x4*)(orow + c0) = w; }
        if (frow) { *(f32x4*)(frow + c0) = (f32x4){y[0], y[1], y[2], y[3]}; *(f32x4*)(frow + c0 + 4) = (f32x4){y[4], y[5], y[6], y[7]}; }
    }
}
__device__ __forceinline__ void load_gb(const float* g, const float* b, int lane, float (&gv)[16], float (&bv)[16]) {
#pragma unroll
    for (int hh = 0; hh < 2; ++hh)
#pragma unroll
        for (int q4 = 0; q4 < 2; ++q4) {
            const f32x4 a = *(const f32x4*)(g + hh * 512 + 8 * lane + 4 * q4), c = *(const f32x4*)(b + hh * 512 + 8 * lane + 4 * q4);
#pragma unroll
            for (int e = 0; e < 4; ++e) { gv[hh * 8 + q4 * 4 + e] = a[e]; bv[hh * 8 + q4 * 4 + e] = c[e]; }
        }
}

__device__ __forceinline__ void phase_prologue(LAS unsigned char* lds, const Params& p) {
    const int tid = opaque_tid(), lane = tid & 63, w = tid >> 6, G = gridDim.x, bx = blockIdx.x;
    unsigned char* ws = p.ws;
    LAS float* tile = (LAS float*)lds;
    for (int t = bx; t < 3648; t += G) {
        if (t < 1024) { const int l = t >> 9, r = t & 511, nt = r >> 3, kt = r & 7; transpose_tile(tile, p.w_up + (size_t)l * 1024 * 4096, 4096, (bf16*)(ws + WS_WUP) + (size_t)l * 4096 * 1024, 1024, nt * 64, kt * 128, false); }
        else if (t < 2048) { const int u = t - 1024, l = u >> 9, r = u & 511, nt = r >> 5, kt = r & 31; transpose_tile(tile, p.w_down + (size_t)l * 4096 * 1024, 1024, (bf16*)(ws + WS_WDN) + (size_t)l * 1024 * 4096, 4096, nt * 64, kt * 128, false); }
        else if (t < 2304) { const int u = t - 2048, l = u >> 7, r = u & 127, nt = r >> 3, kt = r & 7; transpose_tile(tile, p.w_out + (size_t)l * 1024 * 1024, 1024, (bf16*)(ws + WS_WOUT) + (size_t)l * 1024 * 1024, 1024, nt * 64, kt * 128, false); }
        else if (t < 2432) { const int u = t - 2304, l = u >> 6, r = u & 63, nt = r >> 2, kt = r & 3; transpose_tile(tile, p.w_fp + (size_t)l * 512 * 1024, 1024, (bf16*)(ws + WS_WFP) + (size_t)l * 1024 * 512, 512, nt * 64, kt * 128, false); }
        else if (t < 2560) { const int u = t - 2432, l = u >> 6, r = u & 63, nt = r >> 2, kt = r & 3; transpose_tile(tile, p.w_dp + (size_t)l * 512 * 1024, 1024, (bf16*)(ws + WS_WDP) + (size_t)l * 1024 * 512, 512, nt * 64, kt * 128, false); }
        else { const int u = t - 2560, l = u / 544, r = u % 544, nt = r >> 3, kt = r & 7; transpose_tile(tile, p.w_in + (size_t)l * 1024 * INW, INW, (bf16*)(ws + WS_WIN) + (size_t)l * NIN * 1024, 1024, 512 + nt * 64, kt * 128, true); }
    }
    {
        LAS float* tab = (LAS float*)lds;
        LAS float* inb = tab + 128;
        if (tid < 128) tab[tid] = cospif((float)tid * (1.0f / 64.0f));
        __syncthreads();
        for (int it = bx; it < 2 * 4 * 256; it += G) {
            const int l = it >> 10, g = (it >> 8) & 3, k0 = (it & 255) * 4;
            __syncthreads();
            { const int kk = tid >> 7, c = tid & 127; inb[kk * 128 + c] = p.w_in[(size_t)l * 1024 * INW + (size_t)(k0 + kk) * INW + g * 128 + c]; }
            __syncthreads();
            const int kk = tid >> 7, pos = tid & 127;
            const int f = pos <= 64 ? pos : pos - 64, sh = pos <= 64 ? 0 : 96;
            float s = 0.f;
#pragma unroll 8
            for (int c = 0; c < 128; ++c) s += inb[kk * 128 + c] * tab[(c * f + sh) & 127];
            ((bf16*)(ws + WS_WIN))[(size_t)l * NIN * 1024 + (size_t)(g * 128 + pos) * 1024 + k0 + kk] = f2bf(s);
        }
        __syncthreads();
    }
    {
        float gv[16], bv[16]; load_gb(p.ln0g, p.ln0b, lane, gv, bv);
        for (int r0 = (bx * 8 + w) * 2; r0 < NROWS; r0 += G * 16) {
            float v[2][16]; bool pad[2];
#pragma unroll
            for (int k = 0; k < 2; ++k) {
                const int r = r0 + k; int b, pp; pos_of(r, b, pp); pad[k] = pp < PADR;
                const float* src = pp < 64 ? p.meta + (size_t)(pp < PADR ? 0 : pp - PADR) * 1024 : p.x + ((size_t)b * SEQ + (pp - 64)) * 1024;
#pragma unroll
                for (int hh = 0; hh < 2; ++hh) { const f32x4 a = *(const f32x4*)(src + hh * 512 + 8 * lane), c = *(const f32x4*)(src + hh * 512 + 8 * lane + 4);
#pragma unroll
                    for (int e = 0; e < 4; ++e) { v[k][hh * 8 + e] = a[e]; v[k][hh * 8 + 4 + e] = c[e]; } }
            }
#pragma unroll
            for (int k = 0; k < 2; ++k) {
                bf16* orow = (bf16*)(ws + WS_XB) + (size_t)(r0 + k) * 1024;
                if (pad[k]) { *(u32x4*)(orow + 8 * lane) = (u32x4){0u, 0u, 0u, 0u}; *(u32x4*)(orow + 512 + 8 * lane) = (u32x4){0u, 0u, 0u, 0u}; }
                else ln_row_store(v[k], gv, bv, lane, orow, nullptr);
            }
        }
    }
    {
        __syncthreads();
        LAS float* tab = (LAS float*)lds;
        for (int m = tid; m < LTOK; m += NT) tab[m] = cospif((float)m * (1.0f / 2056.0f));
        __syncthreads();
        bf16* Cm = (bf16*)(ws + WS_CM); bf16* Sm = (bf16*)(ws + WS_SM);
        const int total = 2 * DFT_M * (DFT_K / 2);
        for (int i = bx * NT + tid; i < total; i += G * NT) {
            const int par = i / (DFT_M * (DFT_K / 2)), rem = i % (DFT_M * (DFT_K / 2)), l = rem / (DFT_K / 2), k = (rem % (DFT_K / 2)) * 2;
            float c0 = 0.f, s0 = 0.f, c1 = 0.f, s1 = 0.f;
            if (l <= HALF_L / 2) {
                const int j0 = 2 * k + par, j1 = 2 * (k + 1) + par;
                if (j0 <= HALF_L) { const int m = (l * j0) % LTOK, ms = m >= 1028 ? m - 1028 : m + 3084; c0 = tab[m]; s0 = tab[ms]; }
                if (j1 <= HALF_L) { const int m = (l * j1) % LTOK, ms = m >= 1028 ? m - 1028 : m + 3084; c1 = tab[m]; s1 = tab[ms]; }
            }
            *(unsigned*)(Cm + ((size_t)par * DFT_M + l) * DFT_K + k) = pack2(c0, c1);
            *(unsigned*)(Sm + ((size_t)par * DFT_M + l) * DFT_K + k) = pack2(s0, s1);
        }
        __syncthreads();
    }
}

__device__ __forceinline__ void phase_fold(LAS unsigned char* lds, const Params& p) {
    const int tid = opaque_tid(), G = gridDim.x, bx = blockIdx.x;
    const bf16* UF = (const bf16*)(p.ws + WS_UF); bf16* EcT = (bf16*)(p.ws + WS_ECT); bf16* EsT = (bf16*)(p.ws + WS_EST);
    LAS float* tile = (LAS float*)lds;
    for (int it = bx; it < 32 * 36; it += G) {
        const int bg = it / 36, jt = it % 36, b = bg >> 2, g = bg & 3, j0 = jt * 64;
        bf16 u1[16], u2[16];
#pragma unroll
        for (int e = 0; e < 16; ++e) {
            const int idx = tid + NT * e, jj = idx >> 7, pos = idx & 127, j = j0 + jj;
            const int ja = j <= HALF_L ? j : 0, jb = (j > 0 && j < HALF_L) ? LTOK - j : ja;
            u1[e] = UF[(size_t)row_of(b, PADR + ja) * 512 + g * 128 + pos];
            u2[e] = UF[(size_t)row_of(b, PADR + jb) * 512 + g * 128 + pos];
        }
#pragma unroll
        for (int e = 0; e < 16; ++e) {
            const int idx = tid + NT * e, jj = idx >> 7, pos = idx & 127, j = j0 + jj;
            float val = 0.f;
            if (j <= HALF_L) {
                const float a = bf2f(u1[e]), c = bf2f(u2[e]);
                if (j == 0 || j == HALF_L) val = pos <= 64 ? a : 0.f;
                else val = pos <= 64 ? a + c : a - c;
            }
            tile[jj * 129 + pos] = val;
        }
        __syncthreads();
#pragma unroll
        for (int e = 0; e < 16; ++e) {
            const int idx = tid + NT * e, pos = idx >> 6, jj = idx & 63;
            const float v = tile[jj * 129 + pos];
            const int j = j0 + jj, par = j & 1, k = j >> 1;
            if (pos <= 64) EcT[((size_t)par * DFT_NC + bg * 65 + pos) * DFT_K + k] = f2bf(v);
            else EsT[((size_t)par * DFT_NS + bg * 63 + pos - 65) * DFT_K + k] = f2bf(v);
        }
        __syncthreads();
    }
    for (int par = 0; par < 2; ++par) {
        for (int i = bx * NT + tid; i < 224 * (DFT_K / 2); i += G * NT) ((unsigned*)(EcT + ((size_t)par * DFT_NC + 2080) * DFT_K))[i] = 0u;
        for (int i = bx * NT + tid; i < 32 * (DFT_K / 2); i += G * NT) ((unsigned*)(EsT + ((size_t)par * DFT_NS + 2016) * DFT_K))[i] = 0u;
    }
}

__device__ __forceinline__ void phase_unfold(LAS unsigned char* lds, const Params& p) {
    const int tid = opaque_tid(), lane = tid & 63, w = tid >> 6, G = gridDim.x, bx = blockIdx.x;
    const float* P = (const float*)(p.ws + WS_P); const float* Q = (const float*)(p.ws + WS_Q); bf16* FM = (bf16*)(p.ws + WS_UF);
    const float scale = 1.0f / sqrtf((float)LTOK * 128.0f);
    const int g = lane >> 4, cb = (8 * lane) & 127;
    LAS float* strip = (LAS float*)lds + w * (4 * 4 * 264);
    for (int r0 = (bx * 8 + w) * 4; r0 < NROWS; r0 += G * 32) {
        float sg[4]; bool pad[4], hi[4];
#pragma unroll
        for (int k = 0; k < 4; ++k) {
            const int r = r0 + k; int b, pp; pos_of(r, b, pp); pad[k] = pp < PADR;
            const int l = pad[k] ? 0 : pp - PADR, lf = l <= HALF_L ? l : LTOK - l; sg[k] = l <= HALF_L ? 1.f : -1.f;
            hi[k] = lf > HALF_L / 2; const int lh = hi[k] ? HALF_L - lf : lf;
            const float* Pe = P + (size_t)lh * DFT_NC + b * 260; const float* Po = Pe + (size_t)DFT_M * DFT_NC;
            const float* Qe = Q + (size_t)lh * DFT_NS + b * 252; const float* Qo = Qe + (size_t)DFT_M * DFT_NS;
            float va[5], vb[5], vc[4], vd[4];
#pragma unroll
            for (int q = 0; q < 5; ++q) { const int i = q * 64 + lane; va[q] = i < 260 ? Pe[i] : 0.f; vb[q] = i < 260 ? Po[i] : 0.f; }
#pragma unroll
            for (int q = 0; q < 4; ++q) { const int i = q * 64 + lane; vc[q] = i < 252 ? Qe[i] : 0.f; vd[q] = i < 252 ? Qo[i] : 0.f; }
            LAS float* sk = strip + k * (4 * 264);
#pragma unroll
            for (int q = 0; q < 5; ++q) { const int i = q * 64 + lane; if (i < 264) { sk[i] = va[q]; sk[264 + i] = vb[q]; } }
#pragma unroll
            for (int q = 0; q < 4; ++q) { const int i = q * 64 + lane; sk[528 + i] = vc[q]; sk[792 + i] = vd[q]; }
        }
        asm volatile("s_waitcnt lgkmcnt(0)" ::: "memory");
#pragma unroll
        for (int k = 0; k < 4; ++k) {
            const LAS float* sk = strip + k * (4 * 264);
            const float so = hi[k] ? -1.f : 1.f;
            bf16* orow = FM + (size_t)(r0 + k) * 512 + 8 * lane;
            float y[8];
#pragma unroll
            for (int e = 0; e < 8; ++e) {
                const int cp = cb + e, c = cp <= 64 ? cp : 128 - cp;
                const float pv = sk[g * 65 + c] + so * sk[264 + g * 65 + c];
                float qv = 0.f;
                if (c >= 1 && c <= 63) { const float qe = sk[528 + g * 63 + c - 1], qo = sk[792 + g * 63 + c - 1]; qv = hi[k] ? qo - qe : qe + qo; }
                y[e] = pad[k] ? 0.f : (cp <= 64 ? pv - sg[k] * qv : pv + sg[k] * qv) * scale;
            }
            u32x4 wv; wv.x = pack2(y[0], y[1]); wv.y = pack2(y[2], y[3]); wv.z = pack2(y[4], y[5]); wv.w = pack2(y[6], y[7]); *(u32x4*)orow = wv;
        }
        asm volatile("s_waitcnt lgkmcnt(0)" ::: "memory");
    }
}

__device__ __forceinline__ void phase_combine(const Params& p, int layer, int first_wg, int nwg, int nrows) {
    const int tid = opaque_tid(), lane = tid & 63, w = tid >> 6, G = nwg, bx = (int)blockIdx.x - first_wg;
    if (bx < 0) return;
    bf16* OF = (bf16*)(p.ws + WS_OF); const bf16* OB = (const bf16*)(p.ws + WS_OB); const bf16* Z = (const bf16*)(p.ws + WS_Z);
    const float* ng = p.dng + layer * 128 + ((8 * lane) & 127);
    float gv[8];
#pragma unroll
    for (int e = 0; e < 8; ++e) gv[e] = ng[e];
    for (int r0 = (bx * 8 + w) * 4; r0 < nrows; r0 += G * 32) {
        u32x4 ua[4], ub[4], uz[4];
#pragma unroll
        for (int k = 0; k < 4; ++k) { const size_t off = (size_t)(r0 + k) * 512 + 8 * lane; ua[k] = *(const u32x4*)(OF + off); ub[k] = *(const u32x4*)(OB + off); uz[k] = *(const u32x4*)(Z + off); }
#pragma unroll
        for (int k = 0; k < 4; ++k) {
            const size_t off = (size_t)(r0 + k) * 512 + 8 * lane;
            f32x4 a0, a1, b0, b1, z0, z1;
            pg8::unpack8(ua[k], a0, a1); pg8::unpack8(ub[k], b0, b1); pg8::unpack8(uz[k], z0, z1);
            a0 = a0 + b0; a1 = a1 + b1;
            float ss = a0[0] * a0[0] + a0[1] * a0[1] + a0[2] * a0[2] + a0[3] * a0[3] + a1[0] * a1[0] + a1[1] * a1[1] + a1[2] * a1[2] + a1[3] * a1[3];
            ss += dpp_f<0x128>(ss); ss += dpp_f<0x124>(ss); ss += dpp_f<0x122>(ss); ss += dpp_f<0x121>(ss);
            const float rn = rsqrtf(ss * (1.0f / 128.0f) + 1e-6f);
            float y[8];
#pragma unroll
            for (int e = 0; e < 4; ++e) { y[e] = a0[e] * rn * gv[e] * z0[e]; y[4 + e] = a1[e] * rn * gv[4 + e] * z1[e]; }
            u32x4 wv; wv.x = pack2(y[0], y[1]); wv.y = pack2(y[2], y[3]); wv.z = pack2(y[4], y[5]); wv.w = pack2(y[6], y[7]); *(u32x4*)(OF + off) = wv;
        }
    }
}

__device__ __forceinline__ void phase_ln(const Params& p, const float* g, const float* b, bool final_, const float* T, int nparts, int nrows) {
    const int tid = opaque_tid(), lane = tid & 63, w = tid >> 6, G = gridDim.x, bx = blockIdx.x;
    bf16* XB = (bf16*)(p.ws + WS_XB);
    float gv[16], bv[16]; load_gb(g, b, lane, gv, bv);
    for (int r0 = (bx * 8 + w) * 8; r0 < NMAIN; r0 += G * 64) {
        u32x4 u0[8], u1[8];
#pragma unroll
        for (int k = 0; k < 8; ++k) { bf16* row = XB + (size_t)(r0 + k) * 1024; u0[k] = *(const u32x4*)(row + 8 * lane); u1[k] = *(const u32x4*)(row + 512 + 8 * lane); }
#pragma unroll
        for (int k = 0; k < 8; ++k) {
            const int r = r0 + k;
            bf16* row = XB + (size_t)r * 1024;
            f32x4 a0, a1, c0, c1;
            pg8::unpack8(u0[k], a0, a1); pg8::unpack8(u1[k], c0, c1);
            float v[16];
#pragma unroll
            for (int e = 0; e < 4; ++e) { v[e] = a0[e]; v[4 + e] = a1[e]; v[8 + e] = c0[e]; v[12 + e] = c1[e]; }
            ln_row_store(v, gv, bv, lane, final_ ? nullptr : row, final_ ? p.out + (size_t)r * 1024 : nullptr);
        }
    }
    for (int r = NMAIN + bx * 8 + w; r < nrows; r += G * 8) {
        bf16* row = XB + (size_t)r * 1024;
        f32x4 a0, a1, c0, c1;
        pg8::unpack8(*(const u32x4*)(row + 8 * lane), a0, a1); pg8::unpack8(*(const u32x4*)(row + 512 + 8 * lane), c0, c1);
        float v[16];
#pragma unroll
        for (int e = 0; e < 4; ++e) { v[e] = a0[e]; v[4 + e] = a1[e]; v[8 + e] = c0[e]; v[12 + e] = c1[e]; }
        if (T != nullptr) {
            float acc[16];
#pragma unroll
            for (int e = 0; e < 16; ++e) acc[e] = 0.f;
            for (int pt0 = 0; pt0 < nparts; pt0 += 4) {
                f32x4 x[4][4];
#pragma unroll
                for (int q = 0; q < 4; ++q) {
                    const float* tp = T + ((size_t)(pt0 + q) * 512 + (r - NMAIN)) * 1024;
#pragma unroll
                    for (int hh = 0; hh < 2; ++hh) { x[q][hh * 2] = *(const f32x4*)(tp + hh * 512 + 8 * lane); x[q][hh * 2 + 1] = *(const f32x4*)(tp + hh * 512 + 8 * lane + 4); }
                }
#pragma unroll
                for (int q = 0; q < 4; ++q)
#pragma unroll
                    for (int hh = 0; hh < 2; ++hh)
#pragma unroll
                        for (int e = 0; e < 4; ++e) { acc[hh * 8 + e] += x[q][hh * 2][e]; acc[hh * 8 + 4 + e] += x[q][hh * 2 + 1][e]; }
            }
#pragma unroll
            for (int e = 0; e < 16; ++e) v[e] = ALPHA * v[e] + acc[e];
        }
        ln_row_store(v, gv, bv, lane, final_ ? nullptr : row, nullptr);
    }
}
constexpr int L_KS = 0, L_QS = 17408, L_VBT = 34816, L_KBET = 53248, L_KTT = 71680, L_ATT = 90112, L_TS = 99328, L_LM = 108544, L_TF = 126976;
constexpr int KP = 136, TP = 72;

__device__ __forceinline__ f32x4 mma16(const LAS bf16* A, int lda, const LAS bf16* Bt, int ldb, int ksteps, int lane, f32x4 acc) {
    const int l15 = lane & 15, quad = lane >> 4;
    const LAS bf16* ap = A + l15 * lda + quad * 8; const LAS bf16* bp = Bt + l15 * ldb + quad * 8;
    for (int ks = 0; ks < ksteps; ++ks) acc = __builtin_amdgcn_mfma_f32_16x16x32_bf16(lds_frag(ap + 32 * ks), lds_frag(bp + 32 * ks), acc, 0, 0, 0);
    return acc;
}

__device__ __forceinline__ int seg_start(int s) { return 16 * s; }

typedef float f32x2v __attribute__((ext_vector_type(2)));
struct D2Pre { unsigned xu[3][12]; float cw[3][5][2]; float bl, dl; };
__device__ __forceinline__ void d2_prefetch(D2Pre& r, const Params& p, int layer, int dir, int b, int h, int n, int w, int lane) {
    const int cn = dir ? 64 - n : n;
    const unsigned char* BD = p.ws + WS_BD + (size_t)row_of(b, 64 * cn) * 64 + (dir * 4 + h) * 4;
    const unsigned oboff = (unsigned)(dir ? 63 - lane : lane) * 64u;
    r.bl = *(const float*)(BD + (size_t)oboff); r.dl = *(const float*)(BD + 32 + (size_t)oboff);
    const unsigned l4 = (unsigned)lane * 4u, l8 = (unsigned)lane * 8u;
#pragma unroll
    for (int j = 0; j < 5; ++j) {
        const unsigned char* cp = (const unsigned char*)(p.conv_w + (size_t)(layer * 5 + j) * 1536 + h * 128);
#pragma unroll
        for (int t = 0; t < 3; ++t) { const f32x2v v = *(const f32x2v*)(cp + t * 2048 + (size_t)l8); r.cw[t][j][0] = v.x; r.cw[t][j][1] = v.y; }
    }
    const int pp0 = 64 * cn + 8 * w - 2;
    if (cn >= 2 && cn <= 63) {
        const unsigned char* rp = p.ws + WS_QKV + ((size_t)row_of(b, pp0) * 1536 + h * 128) * 2;
#pragma unroll
        for (int rr = 0; rr < 12; ++rr) {
            const unsigned ro = l4 + (unsigned)rr * 3072u;
#pragma unroll
            for (int t = 0; t < 3; ++t) r.xu[t][rr] = *(const unsigned*)(rp + t * 1024 + (size_t)ro);
        }
    } else {
#pragma unroll
        for (int rr = 0; rr < 12; ++rr) {
            const int pp = pp0 + rr;
#pragma unroll
            for (int t = 0; t < 3; ++t) {
                unsigned u = 0u;
                if (pp >= PADR && pp < LPAD) { const unsigned char* rp = p.ws + WS_QKV + ((size_t)row_of(b, pp) * 1536 + t * 512 + h * 128) * 2; u = *(const unsigned*)(rp + (size_t)l4); }
                r.xu[t][rr] = u;
            }
        }
    }
}
__device__ __forceinline__ u32x4 pack8dir(const float (&v)[8], int dir) {
    u32x4 a, bq;
    a.x = pack2(v[0], v[1]); a.y = pack2(v[2], v[3]); a.z = pack2(v[4], v[5]); a.w = pack2(v[6], v[7]);
    bq.x = pack2(v[7], v[6]); bq.y = pack2(v[5], v[4]); bq.z = pack2(v[3], v[2]); bq.w = pack2(v[1], v[0]);
    return dir ? bq : a;
}

__device__ __forceinline__ f32x4 bf4_to_f32(u32x2 v) { return (f32x4){__uint_as_float(v.x << 16), __uint_as_float(v.x & 0xffff0000u), __uint_as_float(v.y << 16), __uint_as_float(v.y & 0xffff0000u)}; }
template <int KS> __device__ __forceinline__ void ldfr(bf16x8 (&f)[KS], const LAS bf16* rowtile, int pitch, int lane) {
    const LAS bf16* q = rowtile + (lane & 15) * pitch + (lane >> 4) * 8;
#pragma unroll
    for (int ks = 0; ks < KS; ++ks) f[ks] = lds_frag(q + 32 * ks);
}
template <int KS> __device__ __forceinline__ f32x4 mmaf(const bf16x8 (&a)[KS], const bf16x8 (&b)[KS], f32x4 acc) {
#pragma unroll
    for (int ks = 0; ks < KS; ++ks) acc = __builtin_amdgcn_mfma_f32_16x16x32_bf16(a[ks], b[ks], acc, 0, 0, 0);
    return acc;
}
constexpr int L_GS = 145408, L_BS = 145664, L_ES = 145920;

__device__ __forceinline__ void d2_item(LAS unsigned char* lds, const Params& p, int layer, int dir, int b, int h, int n, unsigned char* slot, D2Pre& pre,
                                        bool has_next, int ndir, int nb, int nh, int nn) {
    const int tid = opaque_tid(), lane = tid & 63, w = __builtin_amdgcn_readfirstlane(tid >> 6), quad = lane >> 4, l15 = lane & 15;
    LAS bf16* kS = (LAS bf16*)(lds + L_KS); LAS bf16* qS = (LAS bf16*)(lds + L_QS); LAS bf16* vbT = (LAS bf16*)(lds + L_VBT); LAS bf16* kbeT = (LAS bf16*)(lds + L_KBET);
    LAS bf16* ktT = (LAS bf16*)(lds + L_KTT); LAS bf16* attS = (LAS bf16*)(lds + L_ATT); LAS bf16* TS = (LAS bf16*)(lds + L_TS);
    LAS float* Lm = (LAS float*)(lds + L_LM); LAS float* Tf = (LAS float*)(lds + L_TF);
    LAS bf16* valT = (LAS bf16*)(lds + L_LM); LAS bf16* kcdT = (LAS bf16*)(lds + L_TF);
    LAS float* gS = (LAS float*)(lds + L_GS); LAS float* bS = (LAS float*)(lds + L_BS); LAS float* eS = (LAS float*)(lds + L_ES);
    const int cn = dir ? 64 - n : n;
    float beta_l, gc_l, glast;
    {
        const int oi = dir ? 63 - lane : lane; const bool valid = (64 * cn + oi) >= PADR;
        beta_l = valid ? sigmoidf_(pre.bl) : 0.f;
        const float xx = pre.dl + p.dt_bias[layer * 8 + dir * 4 + h];
        const float sp = xx > 15.f ? xx : __logf(1.0f + __expf(xx));
        float g = valid ? -__expf(p.a_log[layer * 8 + dir * 4 + h]) * sp : 0.f;
        { float t;
          t = __int_as_float(__builtin_amdgcn_update_dpp(0, __float_as_int(g), 0x111, 0xf, 0xf, true)); g += t;
          t = __int_as_float(__builtin_amdgcn_update_dpp(0, __float_as_int(g), 0x112, 0xf, 0xf, true)); g += t;
          t = __int_as_float(__builtin_amdgcn_update_dpp(0, __float_as_int(g), 0x114, 0xf, 0xf, true)); g += t;
          t = __int_as_float(__builtin_amdgcn_update_dpp(0, __float_as_int(g), 0x118, 0xf, 0xf, true)); g += t;
          const float r0 = rdlane(g, 15), r1 = rdlane(g, 31), r2 = rdlane(g, 47);
          const int row = lane >> 4;
          g += (row >= 1 ? r0 : 0.f) + (row >= 2 ? r1 : 0.f) + (row >= 3 ? r2 : 0.f); }
        gc_l = g; glast = rdlane(g, 63);
        if (w == 0) { gS[lane] = gc_l; bS[lane] = beta_l; eS[lane] = __expf(gc_l); }
    }
#ifndef EXP
#define EXP 0
#endif
#pragma unroll 1
    for (int repB = 0; repB < (EXP == 9 ? 2 : 1); ++repB) {
        const int i0 = dir ? 56 - 8 * w : 8 * w;
        const int npad = cn == 0 ? (PADR - 8 * w) : 0;
#pragma unroll
        for (int t = 0; t < 3; ++t) {
            f32x2v xv[12], cwv[5], y[8];
#pragma unroll
            for (int rr = 0; rr < 12; ++rr) { const unsigned u = pre.xu[t][rr]; xv[rr] = (f32x2v){__uint_as_float(u << 16), __uint_as_float(u & 0xffff0000u)}; }
#pragma unroll
            for (int j = 0; j < 5; ++j) cwv[j] = (f32x2v){pre.cw[t][j][0], pre.cw[t][j][1]};
#pragma unroll
            for (int tt = 0; tt < 8; ++tt) {
                f32x2v a = cwv[0] * xv[tt];
#pragma unroll
                for (int j = 1; j < 5; ++j) a = cwv[j] * xv[tt + j] + a;
                const f32x2v s = a * (-1.4426950408889634f);
                f32x2v e; e.x = __builtin_amdgcn_exp2f(s.x); e.y = __builtin_amdgcn_exp2f(s.y);
                e = e + 1.0f;
                f32x2v r; r.x = __builtin_amdgcn_rcpf(e.x); r.y = __builtin_amdgcn_rcpf(e.y);
                y[tt] = a * r;
            }
            if (npad > 0) {
#pragma unroll
                for (int tt = 0; tt < 8; ++tt) if (tt < npad) y[tt] = (f32x2v){0.f, 0.f};
            }
            if (t == 0) {
#pragma unroll
                for (int tt = 0; tt < 8; ++tt) {
                    const int oi = 8 * w + tt, i = dir ? 63 - oi : oi;
                    const f32x2v sq = y[tt] * y[tt];
                    const float rn = rsqrtf(wave_sum_dpp(sq.x + sq.y) + 1e-6f) * 0.08838834764831845f;
                    const f32x2v q = y[tt] * rn;
                    *(LAS unsigned*)(qS + i * KP + 2 * lane) = pack2(q.x, q.y);
                }
            } else if (t == 1) {
                float o0[8], o1[8], p0[8], p1[8];
#pragma unroll
                for (int tt = 0; tt < 8; ++tt) {
                    const int oi = 8 * w + tt, i = dir ? 63 - oi : oi;
                    const float bi = rdlane(beta_l, i), gci = rdlane(gc_l, i);
                    const f32x2v sq = y[tt] * y[tt];
                    const float rn = rsqrtf(wave_sum_dpp(sq.x + sq.y) + 1e-6f);
                    const f32x2v k = y[tt] * rn;
                    *(LAS unsigned*)(kS + i * KP + 2 * lane) = pack2(k.x, k.y);
                    const float e1 = bi * __expf(gci), e2 = __expf(glast - gci);
                    const f32x2v ka = k * e1, kb = k * e2;
                    o0[tt] = ka.x; o1[tt] = ka.y; p0[tt] = kb.x; p1[tt] = kb.y;
                }
                *(LAS u32x4*)(kbeT + (2 * lane) * TP + i0) = pack8dir(o0, dir); *(LAS u32x4*)(kbeT + (2 * lane + 1) * TP + i0) = pack8dir(o1, dir);
                *(LAS u32x4*)(ktT + (2 * lane) * TP + i0) = pack8dir(p0, dir); *(LAS u32x4*)(ktT + (2 * lane + 1) * TP + i0) = pack8dir(p1, dir);
            } else {
                float o0[8], o1[8];
#pragma unroll
                for (int tt = 0; tt < 8; ++tt) {
                    const int oi = 8 * w + tt, i = dir ? 63 - oi : oi;
                    const f32x2v vb = y[tt] * rdlane(beta_l, i);
                    o0[tt] = vb.x; o1[tt] = vb.y;
                }
                *(LAS u32x4*)(vbT + (2 * lane) * TP + i0) = pack8dir(o0, dir); *(LAS u32x4*)(vbT + (2 * lane + 1) * TP + i0) = pack8dir(o1, dir);
            }
        }
    }
    lds_barrier();
    if (has_next) d2_prefetch(pre, p, layer, ndir, nb, nh, nn, w, lane);
#pragma unroll 1
    for (int repC = 0; repC < (EXP == 12 ? 2 : 1); ++repC) {
        const int mat = w >> 2, tr = w & 3;
        bf16x8 a[4], bq[4][4];
        ldfr<4>(a, (mat ? qS : kS) + 16 * tr * KP, KP, lane);
#pragma unroll
        for (int tc = 0; tc < 4; ++tc) if (tc <= tr) ldfr<4>(bq[tc], kS + 16 * tc * KP, KP, lane);
        const f32x4 g4 = *(const LAS f32x4*)(gS + 16 * tr + 4 * quad), b4 = *(const LAS f32x4*)(bS + 16 * tr + 4 * quad);
        float gcc[4];
#pragma unroll
        for (int tc = 0; tc < 4; ++tc) gcc[tc] = gS[16 * tc + l15];
#pragma unroll
        for (int tc = 0; tc < 4; ++tc) {
            f32x4 acc = (f32x4){0.f, 0.f, 0.f, 0.f};
            if (tc <= tr) acc = mmaf<4>(a, bq[tc], acc);
            const int c = 16 * tc + l15;
#pragma unroll
            for (int j = 0; j < 4; ++j) {
                const int i = 16 * tr + quad * 4 + j;
                const float dec = __expf(fminf(g4[j] - gcc[tc], 0.f));
                if (mat == 0) Lm[i * TP + c] = (i > c) ? b4[j] * acc[j] * dec : 0.f;
                else attS[i * TP + c] = (i >= c) ? f2bf(acc[j] * dec) : (bf16)0;
            }
        }
    }
    lds_barrier();
    if (w == 0) {
        const int blk = lane >> 4, c = lane & 15;
        const LAS float* Lb = Lm + (blk * 16) * TP + blk * 16;
        float t[16];
        t[0] = (c == 0) ? 1.f : 0.f;
        {
            f32x4 L4[8][2];
#pragma unroll
            for (int i = 1; i <= 8; ++i) { L4[i - 1][0] = *(const LAS f32x4*)(Lb + i * TP); L4[i - 1][1] = *(const LAS f32x4*)(Lb + i * TP + 4); }
#pragma unroll
            for (int i = 1; i <= 8; ++i) {
                float s0 = (i == c) ? 1.f : 0.f, s1 = 0.f;
#pragma unroll
                for (int j = 0; j < i; ++j) { const float lv = L4[i - 1][j >> 2][j & 3]; if (j & 1) s1 -= lv * t[j]; else s0 -= lv * t[j]; }
                t[i] = s0 + s1;
            }
        }
        {
            f32x4 L4[7][4];
#pragma unroll
            for (int i = 9; i <= 15; ++i)
#pragma unroll
                for (int q4 = 0; q4 < 4; ++q4) L4[i - 9][q4] = *(const LAS f32x4*)(Lb + i * TP + 4 * q4);
#pragma unroll
            for (int i = 9; i <= 15; ++i) {
                float s0 = (i == c) ? 1.f : 0.f, s1 = 0.f;
#pragma unroll
                for (int j = 0; j < i; ++j) { const float lv = L4[i - 9][j >> 2][j & 3]; if (j & 1) s1 -= lv * t[j]; else s0 -= lv * t[j]; }
                t[i] = s0 + s1;
            }
        }
#pragma unroll
        for (int i = 0; i < 16; ++i) { Tf[(blk * 16 + i) * TP + blk * 16 + c] = t[i]; TS[(blk * 16 + i) * TP + blk * 16 + c] = f2bf(t[i]); }
    } else {
        for (int idx = tid - 64; idx < 6 * 256; idx += NT - 64) {
            const int bk = idx >> 8, e = idx & 255, br = bk < 3 ? 0 : (bk < 5 ? 1 : 2), bc = bk < 3 ? bk + 1 : (bk < 5 ? bk - 1 : 3);
            Tf[(br * 16 + (e >> 4)) * TP + bc * 16 + (e & 15)] = 0.f; TS[(br * 16 + (e >> 4)) * TP + bc * 16 + (e & 15)] = (bf16)0;
        }
    }
    lds_barrier();
    {
        const int base = (tid >> 8) * 32, i = (tid >> 4) & 15, c = tid & 15;
        f32x4 a4[4]; float bv[16];
#pragma unroll
        for (int q4 = 0; q4 < 4; ++q4) a4[q4] = *(const LAS f32x4*)(Lm + (base + 16 + i) * TP + base + 4 * q4);
#pragma unroll
        for (int j = 0; j < 16; ++j) bv[j] = Tf[(base + j) * TP + base + c];
        float s = 0.f;
#pragma unroll
        for (int j = 0; j < 16; ++j) s += a4[j >> 2][j & 3] * bv[j];
        Lm[(base + i) * TP + base + 16 + c] = s;
    }
    lds_barrier();
    {
        const int base = (tid >> 8) * 32, i = (tid >> 4) & 15, c = tid & 15;
        f32x4 a4[4]; float bv[16];
#pragma unroll
        for (int q4 = 0; q4 < 4; ++q4) a4[q4] = *(const LAS f32x4*)(Tf + (base + 16 + i) * TP + base + 16 + 4 * q4);
#pragma unroll
        for (int j = 0; j < 16; ++j) bv[j] = Lm[(base + j) * TP + base + 16 + c];
        float s = 0.f;
#pragma unroll
        for (int j = 0; j < 16; ++j) s -= a4[j >> 2][j & 3] * bv[j];
        Tf[(base + 16 + i) * TP + base + c] = s; TS[(base + 16 + i) * TP + base + c] = f2bf(s);
    }
    lds_barrier();
    {
        const int c = tid & 31, i0 = tid >> 5;
        float bv[32];
#pragma unroll
        for (int j = 0; j < 32; ++j) bv[j] = Tf[j * TP + c];
#pragma unroll
        for (int rep = 0; rep < 2; ++rep) {
            const int ii = i0 + 16 * rep; f32x4 a4[8];
#pragma unroll
            for (int q4 = 0; q4 < 8; ++q4) a4[q4] = *(const LAS f32x4*)(Lm + (32 + ii) * TP + 4 * q4);
            float s0 = 0.f, s1 = 0.f, s2 = 0.f, s3 = 0.f;
#pragma unroll
            for (int j = 0; j < 32; j += 4) { s0 += a4[j >> 2][0] * bv[j]; s1 += a4[j >> 2][1] * bv[j + 1]; s2 += a4[j >> 2][2] * bv[j + 2]; s3 += a4[j >> 2][3] * bv[j + 3]; }
            Lm[ii * TP + 32 + c] = (s0 + s1) + (s2 + s3);
        }
    }
    lds_barrier();
    {
        const int c = tid & 31, i0 = tid >> 5;
        float bv[32];
#pragma unroll
        for (int j = 0; j < 32; ++j) bv[j] = Lm[j * TP + 32 + c];
#pragma unroll
        for (int rep = 0; rep < 2; ++rep) {
            const int ii = i0 + 16 * rep; f32x4 a4[8];
#pragma unroll
            for (int q4 = 0; q4 < 8; ++q4) a4[q4] = *(const LAS f32x4*)(Tf + (32 + ii) * TP + 32 + 4 * q4);
            float s0 = 0.f, s1 = 0.f, s2 = 0.f, s3 = 0.f;
#pragma unroll
            for (int j = 0; j < 32; j += 4) { s0 += a4[j >> 2][0] * bv[j]; s1 += a4[j >> 2][1] * bv[j + 1]; s2 += a4[j >> 2][2] * bv[j + 2]; s3 += a4[j >> 2][3] * bv[j + 3]; }
            TS[(32 + ii) * TP + c] = f2bf(-((s0 + s1) + (s2 + s3)));
        }
    }
    lds_barrier();
#pragma unroll 1
    for (int repE = 0; repE < (EXP == 14 ? 2 : 1); ++repE) {
        const int mat = w >> 2, rp = (w >> 1) & 1, ch = w & 1;
        bf16x8 a[2][2], bq[4][2];
#pragma unroll
        for (int r2 = 0; r2 < 2; ++r2) ldfr<2>(a[r2], TS + 16 * (2 * rp + r2) * TP, TP, lane);
#pragma unroll
        for (int tt = 0; tt < 4; ++tt) ldfr<2>(bq[tt], (mat ? kbeT : vbT) + 16 * (4 * ch + tt) * TP, TP, lane);
#pragma unroll
        for (int r2 = 0; r2 < 2; ++r2)
#pragma unroll
            for (int tt = 0; tt < 4; ++tt) {
                const int tr = 2 * rp + r2, tc = 4 * ch + tt;
                const f32x4 acc = mmaf<2>(a[r2], bq[tt], (f32x4){0.f, 0.f, 0.f, 0.f});
                u32x2 wv; wv.x = pack2(acc[0], acc[1]); wv.y = pack2(acc[2], acc[3]);
                *(LAS u32x2*)((mat ? kcdT : valT) + (16 * tc + l15) * TP + 16 * tr + quad * 4) = wv;
            }
    }
    lds_barrier();
#pragma unroll 1
    for (int repF = 0; repF < (EXP == 10 ? 2 : 1); ++repF) {
        unsigned char* sA = slot + SLOT_A; unsigned char* sQ = slot + SLOT_Q; unsigned char* sN = slot + SLOT_N; unsigned char* sO = slot + SLOT_O;
        {
            bf16x8 a[2], b1[4][2];
            ldfr<2>(a, kcdT + 16 * w * TP, TP, lane);
#pragma unroll
            for (int tc = 0; tc < 4; ++tc) ldfr<2>(b1[tc], attS + 16 * tc * TP, TP, lane);
            float eg[4]; u32x2 q4[4];
#pragma unroll
            for (int tc = 0; tc < 4; ++tc) { eg[tc] = eS[16 * tc + l15]; q4[tc] = *(const LAS u32x2*)(qS + (16 * tc + l15) * KP + 16 * w + 4 * quad); }
#pragma unroll
            for (int tc = 0; tc < 4; ++tc) {
                const f32x4 a1 = mmaf<2>(a, b1[tc], (f32x4){0.f, 0.f, 0.f, 0.f});
                const f32x4 qf = bf4_to_f32(q4[tc]);
                u32x2 wv; wv.x = pack2(qf[0] * eg[tc] - a1[0], qf[1] * eg[tc] - a1[1]); wv.y = pack2(qf[2] * eg[tc] - a1[2], qf[3] * eg[tc] - a1[3]);
                *(u32x2*)(sQ + (size_t)(unsigned)(((tc * 4 + (w >> 1)) * 64 + ((((w & 1) << 1) | (quad >> 1)) * 16 + l15)) * 16 + (quad & 1) * 8)) = wv;
            }
            const int tr = w & 3, tcb = (w >> 2) * 4;
            bf16x8 a2[2], b2[4][2];
            ldfr<2>(a2, attS + 16 * tr * TP, TP, lane);
#pragma unroll
            for (int tt = 0; tt < 4; ++tt) ldfr<2>(b2[tt], valT + 16 * (tcb + tt) * TP, TP, lane);
#pragma unroll
            for (int tt = 0; tt < 4; ++tt) {
                const f32x4 o = mmaf<2>(a2, b2[tt], (f32x4){0.f, 0.f, 0.f, 0.f});
                u32x2 wv; wv.x = pack2(o[0], o[1]); wv.y = pack2(o[2], o[3]);
                *(u32x2*)(sO + (size_t)(unsigned)((((tr * 8 + tcb + tt) * 64 + lane) * 4) * 2)) = wv;
            }
        }
        {
            const int rq = w >> 1, ch = w & 1;
            bf16x8 ak[2][2], at[2][2], bk[4][2], bv[4][2];
#pragma unroll
            for (int r2 = 0; r2 < 2; ++r2) { ldfr<2>(ak[r2], kcdT + 16 * (2 * rq + r2) * TP, TP, lane); ldfr<2>(at[r2], ktT + 16 * (2 * rq + r2) * TP, TP, lane); }
#pragma unroll
            for (int tt = 0; tt < 4; ++tt) { ldfr<2>(bk[tt], ktT + 16 * (4 * ch + tt) * TP, TP, lane); ldfr<2>(bv[tt], valT + 16 * (4 * ch + tt) * TP, TP, lane); }
#pragma unroll
            for (int r2 = 0; r2 < 2; ++r2)
#pragma unroll
                for (int tt = 0; tt < 4; ++tt) {
                    const int rt = 2 * rq + r2, tc = 4 * ch + tt;
                    const f32x4 a1 = mmaf<2>(ak[r2], bk[tt], (f32x4){0.f, 0.f, 0.f, 0.f}), a2 = mmaf<2>(at[r2], bv[tt], (f32x4){0.f, 0.f, 0.f, 0.f});
                    u32x2 wa; wa.x = pack2(-a1[0], -a1[1]); wa.y = pack2(-a1[2], -a1[3]);
                    *(u32x2*)(sA + (size_t)(unsigned)(((tc * 4 + (rt >> 1)) * 64 + ((((rt & 1) << 1) | (quad >> 1)) * 16 + l15)) * 16 + (quad & 1) * 8)) = wa;
                    u32x2 wv; wv.x = pack2(a2[0], a2[1]); wv.y = pack2(a2[2], a2[3]);
                    *(u32x2*)(sN + (size_t)(unsigned)((((rt * 8 + tc) * 64 + lane) * 4) * 2)) = wv;
                }
        }
        if (tid == 0) *(float*)(slot + SLOT_CD) = __expf(glast);
    }
    lds_barrier();
}

__device__ __forceinline__ void phase_d2(LAS unsigned char* lds, const Params& p, int layer, int c0, int nc, unsigned char* slots, int first_wg, int nwg) {
    const int tid = opaque_tid(), lane = tid & 63, w = __builtin_amdgcn_readfirstlane(tid >> 6);
    const int sh = nc == 16 ? 4 : 0, msk = nc - 1;
    const int nitems = 64 * nc;
    int it = (int)blockIdx.x - first_wg;
    if (it < 0) return;
    D2Pre pre;
    if (it < nitems) { const int seq = it >> sh, st = it & msk; d2_prefetch(pre, p, layer, seq >> 5, (seq >> 2) & 7, seq & 3, c0 + st, w, lane); }
    for (; it < nitems; it += nwg) {
        const int seq = it >> sh, st = it & msk, dir = seq >> 5, b = (seq >> 2) & 7, h = seq & 3;
        const int itn = it + nwg; const bool has_next = itn < nitems; const int nseq = has_next ? itn >> sh : 0, nst = has_next ? itn & msk : 0;
        d2_item(lds, p, layer, dir, b, h, c0 + st, slots + (size_t)it * SLOT, pre, has_next, nseq >> 5, (nseq >> 2) & 7, nseq & 3, c0 + nst);
    }
}

struct D3Regs { bf16x8 a[4], q[4]; u32x2 nt[2], ot; float cd; };
struct D3Off { unsigned a, q, n0, n1, o; };
__device__ __forceinline__ D3Off d3_offsets(int w, int lane, int slice) {
    D3Off f; const int l15 = lane & 15, quad = lane >> 4;
    f.a = SLOT_A + ((w * 4) * 64 + lane) * 16;
    f.q = SLOT_Q + (((w >> 1) * 4) * 64 + lane) * 16;
    f.n0 = SLOT_N + ((w * 8 + slice * 2 + 0) * 64 + lane) * 8;
    f.n1 = SLOT_N + ((w * 8 + slice * 2 + 1) * 64 + lane) * 8;
    f.o = SLOT_O + (((w >> 1) * 8 + slice * 2 + (w & 1)) * 64 + lane) * 8;
    return f;
}
__device__ __forceinline__ D3Regs d3_load(const unsigned char* slot, const D3Off& f) {
    D3Regs r;
#pragma unroll
    for (int ks = 0; ks < 4; ++ks) { r.a[ks] = *(const bf16x8*)(slot + (size_t)(f.a + 1024u * ks)); r.q[ks] = *(const bf16x8*)(slot + (size_t)(f.q + 1024u * ks)); }
    r.nt[0] = *(const u32x2*)(slot + (size_t)f.n0); r.nt[1] = *(const u32x2*)(slot + (size_t)f.n1);
    r.ot = *(const u32x2*)(slot + (size_t)f.o);
    r.cd = *(const float*)(slot + SLOT_CD);
    return r;
}

__device__ __forceinline__ void d3_step(const D3Regs& cur, f32x4 (&S)[2], LAS bf16* ST, int cb, unsigned char* obase, const unsigned (&ooff)[4], int w, int lane) {
    const int quad = lane >> 4, l15 = lane & 15, tco = w & 1;
    const LAS bf16* Sc = ST + cb * 32 * KP;
    bf16x8 bf0[4], bf1[4];
    ldfr<4>(bf0, Sc, KP, lane); ldfr<4>(bf1, Sc + 16 * KP, KP, lane);
    f32x4 a0 = S[0] * cur.cd + bf4_to_f32(cur.nt[0]), a1 = S[1] * cur.cd + bf4_to_f32(cur.nt[1]), ao = bf4_to_f32(cur.ot);
    if (tco) {
#pragma unroll
        for (int ks = 0; ks < 4; ++ks) {
            a0 = __builtin_amdgcn_mfma_f32_16x16x32_bf16(cur.a[ks], bf0[ks], a0, 0, 0, 0);
            a1 = __builtin_amdgcn_mfma_f32_16x16x32_bf16(cur.a[ks], bf1[ks], a1, 0, 0, 0);
            ao = __builtin_amdgcn_mfma_f32_16x16x32_bf16(cur.q[ks], bf1[ks], ao, 0, 0, 0);
        }
    } else {
#pragma unroll
        for (int ks = 0; ks < 4; ++ks) {
            a0 = __builtin_amdgcn_mfma_f32_16x16x32_bf16(cur.a[ks], bf0[ks], a0, 0, 0, 0);
            a1 = __builtin_amdgcn_mfma_f32_16x16x32_bf16(cur.a[ks], bf1[ks], a1, 0, 0, 0);
            ao = __builtin_amdgcn_mfma_f32_16x16x32_bf16(cur.q[ks], bf0[ks], ao, 0, 0, 0);
        }
    }
    S[0] = a0; S[1] = a1;
    LAS bf16* Sw = ST + (cb ^ 1) * 32 * KP;
#pragma unroll
    for (int tc = 0; tc < 2; ++tc) { u32x2 wv; wv.x = pack2(S[tc][0], S[tc][1]); wv.y = pack2(S[tc][2], S[tc][3]); *(LAS u32x2*)(Sw + (16 * tc + l15) * KP + 16 * w + quad * 4) = wv; }
#pragma unroll
    for (int j = 0; j < 4; ++j) *(bf16*)(obase + (size_t)ooff[j]) = f2bf(ao[j]);
    lds_barrier();
}

template <int NC> __device__ __forceinline__ void d3_run(LAS unsigned char* lds, const Params& p, int seg, bool dry) {
    const int tid = opaque_tid(), lane = tid & 63, w = __builtin_amdgcn_readfirstlane(tid >> 6), quad = lane >> 4, l15 = lane & 15;
    LAS bf16* ST = (LAS bf16*)lds;
    const int c0 = seg_start(seg);
    for (int wg = blockIdx.x; wg < 256; wg += gridDim.x) {
        const int xcd = wg & 7, idx = wg >> 3, seq = xcd * 8 + (idx >> 2), slice = idx & 3, dir = seq >> 5, b = (seq >> 2) & 7, h = seq & 3;
        float* sst = (float*)(p.ws + WS_SST) + ((size_t)wg * NT + tid) * 8;
        const unsigned char* slot0 = p.ws + WS_DS + (size_t)(seq * 16) * SLOT;
        const unsigned char* slotx = p.ws + WS_DSX + (size_t)seq * SLOT;
        D3Regs r[3];
        const D3Off off = d3_offsets(w, lane, slice);
        r[0] = d3_load(slot0, off); r[1] = d3_load(slot0 + SLOT, off); r[2] = d3_load(slot0 + 2 * SLOT, off);
        f32x4 S[2];
        if (seg == 0) { S[0] = (f32x4){0.f, 0.f, 0.f, 0.f}; S[1] = S[0]; } else { S[0] = *(const f32x4*)sst; S[1] = *(const f32x4*)(sst + 4); }
        lds_barrier();
#pragma unroll
        for (int tc = 0; tc < 2; ++tc) { u32x2 wv; wv.x = pack2(S[tc][0], S[tc][1]); wv.y = pack2(S[tc][2], S[tc][3]); *(LAS u32x2*)(ST + (16 * tc + l15) * KP + 16 * w + quad * 4) = wv; }
        lds_barrier();
        unsigned char* obuf = p.ws + (dir ? WS_OB : WS_OF);
        unsigned ooff[4];
#pragma unroll
        for (int j = 0; j < 4; ++j) { const int rj = 16 * (w >> 1) + quad * 4 + j; ooff[j] = (unsigned)((dir ? (63 - rj) : rj) * 1024 + (h * 128 + slice * 32 + 16 * (w & 1) + l15) * 2); }
        const unsigned char* sp = slot0 + 3 * SLOT;
        int ncur = c0;
#pragma unroll
        for (int st = 0; st < NC; ++st) {
            unsigned char* ob = obuf + (size_t)row_of(b, 64 * (dir ? 64 - ncur : ncur)) * 1024;
            d3_step(r[st % 3], S, ST, st & 1, ob, ooff, w, lane);
            if (st + 3 < NC) { r[st % 3] = d3_load(st + 3 == 16 ? slotx : sp, off); sp = opaque_ptr(sp + SLOT); }
            asm volatile("" : "+s"(ncur)); ncur += 1;
        }
        if (NC & 1) {
        }
        if (!dry) { *(f32x4*)sst = S[0]; *(f32x4*)(sst + 4) = S[1]; }
    }
}
__device__ __forceinline__ void phase_d3(LAS unsigned char* lds, const Params& p, int seg, bool dry = false) {
    if (seg == 3) d3_run<17>(lds, p, seg, dry); else d3_run<16>(lds, p, seg, dry);
}

__global__ void __launch_bounds__(NT, 2) fwd_kernel(Params p_in) {
    extern __shared__ __attribute__((aligned(16))) unsigned char lds_raw[];
    LAS unsigned char* lds = (LAS unsigned char*)lds_raw;
    cg::grid_group grid = cg::this_grid();
    typedef const __attribute__((address_space(4))) Params* KP;
    const KP kp = (KP)__builtin_amdgcn_kernarg_segment_ptr();
    volatile LAS unsigned* xst = (volatile LAS unsigned*)(lds + LDS_BYTES - 16);
    if (threadIdx.x < 4) xst[threadIdx.x] = 0u;
    __syncthreads();
    if (blockIdx.x == 0) { for (int i = threadIdx.x; i < XCD_BAR_WORDS; i += NT) ((unsigned*)(p_in.ws + WS_BAR))[i] = 0u; __threadfence(); }
    grid.sync();
    XcdBarrier xbar = xcd_barrier_post((unsigned*)(p_in.ws + WS_BAR), xst);
    const int G = gridDim.x, bx = blockIdx.x;
    const int ph_lo = p_in.ph_lo, ph_hi = p_in.ph_hi;
    for (int ph0 = ph_lo; ph0 < ph_hi; ++ph0) {
        int ph = ph0; asm volatile("" : "+s"(ph));
        const Params& p = p_in;
        unsigned char* ws = p.ws;
#ifndef EXP
#define EXP 0
#endif
        if (ph == 0) { phase_prologue(lds, p); if (EXP == 2) { __syncthreads(); phase_prologue(lds, p); } }
        else {
            const int layer = (ph - 1) / 18, sub0r = (ph - 1) % 18, sub0 = sub0r <= 12 ? sub0r : sub0r + 1;
            const int sub = sub0 <= 3 ? sub0 : (sub0 <= 10 ? sub0 + 1 : (sub0 == 11 ? 14 : sub0 + 4));
            bool is_gemm = false; int ncall = 1; int tailsplit = 0;
            int d2_c0 = -1, d2_nc = 16, d2_first = 0, d2_nwg = G; unsigned char* d2_slots = ws + WS_DS;
            pg8::Gemm g{nullptr, nullptr, 0, 0, 0}; pg8::Epi E{}; int swz = 1;
            bf16* XB = (bf16*)(ws + WS_XB);
            const int MR = (layer == 1) ? NMAIN : NROWS;
            if (sub == 0) { is_gemm = true; g = pg8::Gemm{XB, (bf16*)(ws + WS_WIN) + (size_t)layer * NIN * 1024, NROWS, N1, 1024, 1024};
                E.mode = pg8::EP_PROJ1; E.uf = (bf16*)(ws + WS_UF); E.qkv = (bf16*)(ws + WS_QKV); E.z = (bf16*)(ws + WS_Z); E.bd = (float*)(ws + WS_BD); }
            else if (sub == 1) { phase_fold(lds, p); if (EXP == 5) { __syncthreads(); phase_fold(lds, p); } }
            else if (sub == 2) { is_gemm = true; ncall = 4; swz = 0; }
            else if (sub == 3) { phase_unfold(lds, p); if (EXP == 5) phase_unfold(lds, p); d2_c0 = 0; }
            else if (sub < 12) { const int s = (sub - 4) >> 1; if ((sub - 4) & 1) { if (EXP == 4) { phase_d3(lds, p, s, true); __syncthreads(); } phase_d3(lds, p, s); } else { d2_c0 = 16 * s; } }
            else if (sub == 14) { is_gemm = true; g = pg8::Gemm{XB, (bf16*)(ws + WS_WIN) + (size_t)layer * NIN * 1024 + (size_t)N1 * 1024, MR, N2, 1024, 1024};
                E.mode = pg8::EP_SIGM; E.o = (bf16*)(ws + WS_G); E.ldc = 2048; }

            else if (sub == 16) { is_gemm = true; g = pg8::Gemm{(bf16*)(ws + WS_UF), (bf16*)(ws + WS_WFP) + (size_t)layer * 1024 * 512, MR, 1024, 512, 512};
                E.mode = pg8::EP_MERGE0; E.o = (bf16*)(ws + WS_TMP); E.ldc = 1024; E.gate = (bf16*)(ws + WS_G); ncall = 2; }
            else if (sub == 17) { is_gemm = true; g = pg8::Gemm{(bf16*)(ws + WS_OF), (bf16*)(ws + WS_WDP) + (size_t)layer * 1024 * 512, MR, 1024, 512, 512};
                E.mode = pg8::EP_MERGE1; E.o = (bf16*)(ws + WS_TMP); E.ldc = 1024; E.gate = (bf16*)(ws + WS_G) + 1024; }
            else if (sub == 18) { is_gemm = true; g = pg8::Gemm{(bf16*)(ws + WS_TMP), (bf16*)(ws + WS_WOUT) + (size_t)layer * 1024 * 1024, MR, 1024, 1024, 1024};
                E.mode = pg8::EP_RES; E.o = XB; E.ldc = 1024; g.M = NMAIN; if (layer == 0) { ncall = 2; tailsplit = 256; } }
            else if (sub == 19) phase_ln(p, p.ln1g + layer * 1024, p.ln1b + layer * 1024, false, layer == 0 ? (const float*)(ws + WS_TOUT) : nullptr, 4, MR);
            else if (sub == 20) { is_gemm = true; g = pg8::Gemm{XB, (bf16*)(ws + WS_WUP) + (size_t)layer * 4096 * 1024, MR, DFF, 1024, 1024};
                E.mode = pg8::EP_SQRELU; E.o = (bf16*)(ws + WS_H); E.ldc = DFF; }
            else if (sub == 21) { is_gemm = true; g = pg8::Gemm{(bf16*)(ws + WS_H), (bf16*)(ws + WS_WDN) + (size_t)layer * 1024 * 4096, MR, 1024, DFF, DFF};
                E.mode = pg8::EP_RES; E.o = XB; E.ldc = 1024; g.M = NMAIN; if (layer == 0) { ncall = 2; tailsplit = 512; } }
            else phase_ln(p, p.ln2g + layer * 1024, p.ln2b + layer * 1024, layer == 1, layer == 0 ? (const float*)(ws + WS_TDN) : nullptr, 8, MR);
            if (is_gemm) {
                for (int call = 0; call < ncall; ++call) {
                    int c = bx;
                    if (sub == 2) {
                        const int par = call & 1, off = call == 0 ? 0 : (call == 1 ? 45 : (call == 2 ? 90 : 130));
                        if (call < 2) g = pg8::Gemm{(bf16*)(ws + WS_CM) + (size_t)par * DFT_M * DFT_K, (bf16*)(ws + WS_ECT) + (size_t)par * DFT_NC * DFT_K, DFT_M, DFT_NC, DFT_K, DFT_K};
                        else g = pg8::Gemm{(bf16*)(ws + WS_SM) + (size_t)par * DFT_M * DFT_K, (bf16*)(ws + WS_EST) + (size_t)par * DFT_NS * DFT_K, DFT_M, DFT_NS, DFT_K, DFT_K};
                        E.mode = pg8::EP_F32; E.ldc = g.N;
                        E.of32 = (float*)(ws + (call < 2 ? WS_P : WS_Q)) + (size_t)par * DFT_M * g.N;
                        c = (bx + G - (off % G)) % G;
                    }
                    if (sub == 16 && call == 1) { g.A = (bf16*)(ws + WS_OF); g.Bt = (bf16*)(ws + WS_WDP) + (size_t)layer * 1024 * 512; E.mode = pg8::EP_MERGE1; E.gate = (bf16*)(ws + WS_G) + 1024; }
                    pg8::Order S; S.init(g.M, g.N, G, c, swz);
                    if (tailsplit && call == 1) {
                        g.K = tailsplit; E.mode = pg8::EP_PART; E.of32 = (float*)(ws + (sub == 18 ? WS_TOUT : WS_TDN)); E.goff = NMAIN;
                        S.init_split(2, NMAIN / 256, 1024, g.ld / tailsplit, tailsplit * 2, G, c);
                    }
                    __syncthreads();
                    pg8::gemm_phase<pg8::Epi, pg8::Order, true, true>(lds, g, S, E);
                    __syncthreads();
                    if (sub == 2 && call == 3) { d2_c0 = 64; d2_nc = 1; d2_slots = ws + WS_DSX; if (G >= 234) { d2_first = 170; d2_nwg = G - 170; } }
                    if (sub == 14) {
                        const int nun = (g.M / 256) * (g.N / 256), tailw = nun % G;
                        __syncthreads();
                        const int cf = (tailw > 0 && tailw < G / 2) ? tailw : 0; phase_combine(p, layer, cf, G - cf, MR);
                    }
                    if (EXP == 6 && sub == 20 && call == 0) { ncall = 2; }
                    if (EXP == 7 && sub == 0 && call == 0) { ncall = 2; }
                }
            }
            if (d2_c0 >= 0) { __syncthreads(); phase_d2(lds, p, layer, d2_c0, d2_nc, d2_slots, d2_first, d2_nwg); }
        }
        if (ph0 + 1 < ph_hi) { xcd_barrier(xbar); if (EXP == 1) xcd_barrier(xbar); }
    }
}

#ifndef N_LAUNCH_MODE
#define N_LAUNCH_MODE 1
#endif
extern "C" void kernel_launch(void* const* d_in, const int* in_sizes, int n_in, void* d_out, int out_size, void* d_ws, size_t ws_size, hipStream_t stream) {
    static int grid = 0;
    if (grid == 0) {
        if (n_in != 18 || ws_size < WS_END) { fprintf(stderr, "kernel_launch: unexpected n_in %d / ws_size %zu (need %zu)\n", n_in, ws_size, (size_t)WS_END); grid = -1; return; }
        int dev = 0, cus = 0, per_cu = 0;
        hipGetDevice(&dev); hipDeviceGetAttribute(&cus, hipDeviceAttributeMultiprocessorCount, dev);
        if (hipFuncSetAttribute((const void*)fwd_kernel, hipFuncAttributeMaxDynamicSharedMemorySize, LDS_BYTES) != hipSuccess) { fprintf(stderr, "kernel_launch: hipFuncSetAttribute failed\n"); grid = -1; return; }
        hipOccupancyMaxActiveBlocksPerMultiprocessor(&per_cu, (const void*)fwd_kernel, NT, LDS_BYTES);
        if (per_cu < 1) { fprintf(stderr, "kernel_launch: occupancy query says %d blocks per CU\n", per_cu); per_cu = 1; }
        (void)hipGetLastError();
        grid = cus * 1;
        fprintf(stderr, "kernel_launch: grid %d (cus %d, per_cu %d)\n", grid, cus, per_cu);
    }
    if (grid < 0) return;
    Params p{};
    const float** pf = (const float**)&p;
    for (int i = 0; i < 18; ++i) pf[i] = (const float*)d_in[i];
    p.out = (float*)d_out; p.ws = (unsigned char*)d_ws;
    const int NPH = 37;
    if (N_LAUNCH_MODE == 1) {
        p.ph_lo = 0; p.ph_hi = NPH;
        void* args[] = {&p};
        hipError_t e = hipLaunchCooperativeKernel((const void*)fwd_kernel, dim3(grid), dim3(NT), args, LDS_BYTES, stream);
        if (e != hipSuccess) fprintf(stderr, "cooperative launch failed: %s (grid %d)\n", hipGetErrorString(e), grid);
    } else {
        for (int ph = 0; ph < NPH; ++ph) {
            p.ph_lo = ph; p.ph_hi = ph + 1;
            void* args[] = {&p};
            hipError_t e = hipLaunchCooperativeKernel((const void*)fwd_kernel, dim3(grid), dim3(NT), args, LDS_BYTES, stream);
            if (e != hipSuccess) { fprintf(stderr, "launch %d failed: %s\n", ph, hipGetErrorString(e)); break; }
        }
    }
}
```

```cpp
#include <hip/hip_runtime.h>
#include <hip/hip_cooperative_groups.h>
#include <cstdio>
#include <cstdint>
namespace cg = cooperative_groups;

#define LAS __attribute__((address_space(3)))
typedef unsigned short bf16;
typedef short bf16x8 __attribute__((ext_vector_type(8)));
typedef float f32x4 __attribute__((ext_vector_type(4)));
typedef unsigned u32x4 __attribute__((ext_vector_type(4)));
typedef unsigned u32x2 __attribute__((ext_vector_type(2)));

constexpr int DM = 1024, NBATCH = 8, SEQ = 4096, NMETA = 16, LTOK = 4112, LPAD = 4160, NROWS = NBATCH * LPAD  , PADR = 48;
constexpr int HALF_L = 2056;
constexpr int NMAIN = NBATCH * SEQ;
__device__ __forceinline__ int row_of(int b, int pp) { return pp >= 64 ? b * SEQ + (pp - 64) : NMAIN + b * 64 + pp; }
__device__ __forceinline__ void pos_of(int r, int& b, int& pp) { if (r < NMAIN) { b = r >> 12; pp = 64 + (r & 4095); } else { const int q = r - NMAIN; b = q >> 6; pp = q & 63; } }
constexpr int DFT_M = 1280, DFT_K = 1152, DFT_NC = 2304, DFT_NS = 2048;
constexpr int N1 = 2816, N2 = 2048, NIN = 4864, DFF = 4096, INW = 4624;
constexpr int NSEG = 4;
constexpr int SLOT_A = 0, SLOT_Q = 32768, SLOT_N = 49152, SLOT_O = 81920, SLOT_CD = 98304, SLOT = 98560;
constexpr float ALPHA = 1.41421356237f;

constexpr size_t MiB = 1048576;
constexpr size_t WS_WIN = 0, WS_WUP = 19 * MiB, WS_WDN = 35 * MiB, WS_WOUT = 51 * MiB, WS_WFP = 55 * MiB, WS_WDP = 57 * MiB, WS_CM = 59 * MiB, WS_SM = 69 * MiB;
constexpr size_t WS_XB = 80 * MiB, WS_H = 145 * MiB, WS_UF = 145 * MiB, WS_QKV = 178 * MiB, WS_TMP = 178 * MiB, WS_Z = 276 * MiB, WS_OF = 309 * MiB, WS_OB = 342 * MiB;
constexpr size_t WS_BD = 375 * MiB, WS_ECT = 309 * MiB, WS_EST = 320 * MiB, WS_P = 329 * MiB, WS_Q = 352 * MiB,     WS_DS = 378 * MiB, WS_G = 378 * MiB, WS_SST = 482 * MiB, WS_DSX = 475 * MiB, WS_TOUT = 300 * MiB, WS_TDN = 410 * MiB;
constexpr size_t WS_BAR = 508 * MiB;
constexpr size_t WS_END = 509 * MiB;
constexpr int LDS_BYTES = 147456;

struct Params {
    const float *x, *meta, *ln0g, *ln0b, *w_in, *conv_w, *a_log, *dt_bias, *dng, *w_fp, *w_dp, *w_out, *ln1g, *ln1b, *w_up, *w_down, *ln2g, *ln2b;
    float* out; unsigned char* ws; int ph_lo, ph_hi;
};

__device__ __forceinline__ int opaque_tid() { int t = threadIdx.x; asm volatile("" : "+v"(t)); return t; }
template <class T> __device__ __forceinline__ T* opaque_ptr(T* q) { asm volatile("" : "+s"(q)); return q; }
__device__ __forceinline__ void lds_barrier() { asm volatile("s_waitcnt lgkmcnt(0)" ::: "memory"); __builtin_amdgcn_s_barrier(); asm volatile("" ::: "memory"); }
__device__ __forceinline__ float bf2f(unsigned short h) { return __uint_as_float(((unsigned)h) << 16); }
typedef float f32x2c __attribute__((ext_vector_type(2)));
typedef __bf16 bf16x2c __attribute__((ext_vector_type(2)));
__device__ __forceinline__ unsigned pack2(float lo, float hi) { const f32x2c v = {lo, hi}; const bf16x2c r = __builtin_convertvector(v, bf16x2c); return __builtin_bit_cast(unsigned, r); }
__device__ __forceinline__ unsigned short f2bf(float f) { return (unsigned short)(pack2(f, 0.f) & 0xffffu); }
__device__ __forceinline__ float wave_sum(float v) {
#pragma unroll
    for (int o = 32; o; o >>= 1) v += __shfl_xor(v, o);
    return v;
}
__device__ __forceinline__ float sigmoidf_(float x) { return __builtin_amdgcn_rcpf(1.0f + __expf(-x)); }
#define XB_TMO      128
#define XB_XCNT(j)  (256  + 64 * (j))
#define XB_XSUB(j)  (1280 + 64 * (j))
#define XB_XGEN(j)  (2304 + 64 * (j))
#define XB_TOP      3328
#define XB_TOPGEN   3392
#define XCD_BAR_WORDS 3456
#define XB_SPIN_CAP (1u << 18)

__device__ __forceinline__ unsigned xb_ld(unsigned* p)              { return __hip_atomic_load(p, __ATOMIC_RELAXED, __HIP_MEMORY_SCOPE_AGENT); }
__device__ __forceinline__ unsigned xb_add(unsigned* p, unsigned v) { return __hip_atomic_fetch_add(p, v, __ATOMIC_RELAXED, __HIP_MEMORY_SCOPE_AGENT); }
__device__ __forceinline__ unsigned xb_xcc_id() { return (unsigned)__builtin_amdgcn_s_getreg((3 << 11) | 20) & 0xFu; }
#define XB_SPIN(cond, bar) do { unsigned _sp = 0; while (cond) { __builtin_amdgcn_s_sleep(1); \
    if ((++_sp & 255u) == 0u) { if (xb_ld(&(bar)[XB_TMO])) break; if (_sp > XB_SPIN_CAP) { atomicAdd(&(bar)[XB_TMO], 1u); break; } } } } while (0)

struct XcdBarrier {
    unsigned* bar; unsigned x;
    volatile LAS unsigned* st;
};

__device__ __forceinline__ XcdBarrier xcd_barrier_post(unsigned* bar, volatile LAS unsigned* st) {
    XcdBarrier b; b.bar = bar; b.x = xb_xcc_id(); b.st = st;
    if (threadIdx.x == 0) (void)xb_add(&bar[XB_XCNT(b.x)], 1u);
    return b;
}
__device__ __forceinline__ void xcd_barrier_complete(unsigned* bar, unsigned x, unsigned& nloc, unsigned& nx) {
    const unsigned G = gridDim.x * gridDim.y * gridDim.z;
    unsigned sum, cnt, mine, sp = 0u;
    for (;;) {
        sum = 0u; cnt = 0u; mine = 0u;
#pragma unroll
        for (unsigned j = 0; j < 16; ++j) { const unsigned c = xb_ld(&bar[XB_XCNT(j)]); sum += c; cnt += (c > 0u) ? 1u : 0u; mine = (j == x) ? c : mine; }
        if (sum == G) break;
        __builtin_amdgcn_s_sleep(1);
        if ((++sp & 255u) == 0u) { if (xb_ld(&bar[XB_TMO])) break; if (sp > XB_SPIN_CAP) { atomicAdd(&bar[XB_TMO], 1u); break; } }
    }
    nloc = mine > 0u ? mine : 1u; nx = cnt > 0u ? cnt : 1u;
}

__device__ __forceinline__ void xcd_barrier(const XcdBarrier& b) {
    asm volatile("s_waitcnt vmcnt(0)" ::: "memory");
    __syncthreads();
    if (threadIdx.x == 0) {
        unsigned* bar = b.bar;
        __builtin_amdgcn_s_waitcnt(0);
        unsigned nloc = b.st[0], nx = b.st[1];
        if (nloc == 0u) { xcd_barrier_complete(bar, b.x, nloc, nx); b.st[0] = nloc; b.st[1] = nx; }
        const unsigned old = xb_add(&bar[XB_XSUB(b.x)], 1u);
        const unsigned gen = old / nloc;
        if (old + 1u == (gen + 1u) * nloc) {
            __builtin_amdgcn_fence(__ATOMIC_RELEASE, "agent");
            asm volatile("s_waitcnt vmcnt(0)" ::: "memory");
            const unsigned og = xb_add(&bar[XB_TOP], 1u);
            const unsigned tg = og / nx;
            if (og + 1u == (tg + 1u) * nx) xb_add(&bar[XB_TOPGEN], 1u);
            else XB_SPIN(xb_ld(&bar[XB_TOPGEN]) == tg, bar);
            __builtin_amdgcn_fence(__ATOMIC_ACQUIRE, "agent");
            xb_add(&bar[XB_XGEN(b.x)], 1u);
            asm volatile("s_waitcnt vmcnt(0)" ::: "memory");
        } else {
            XB_SPIN(xb_ld(&bar[XB_XGEN(b.x)]) == gen, bar);
            __builtin_amdgcn_fence(__ATOMIC_ACQUIRE, "agent");
            asm volatile("s_waitcnt vmcnt(0)" ::: "memory");
        }
    }
    __syncthreads();
}

namespace pg8 {
#define PG8_LAS __attribute__((address_space(3)))
typedef unsigned short bf16_t;
typedef short bf16x8 __attribute__((ext_vector_type(8)));
typedef float f32x4 __attribute__((ext_vector_type(4)));
typedef unsigned u32x4 __attribute__((ext_vector_type(4)));
constexpr int BM = 256, BK = 64, HALF = 128, HTB = HALF * BK * 2  , STAGE_BYTES = 8 * HTB, NXCD = 8, WGM = 8;

__host__ __device__ __forceinline__ int lds_byte(int r, int c) { const int st = (r >> 4) * 2 + (c >> 5), rr = r & 15, cc = c & 31, ob = rr * 64 + cc * 2; return st * 1024 + (ob ^ (((ob >> 9) & 1) << 5)); }
__host__ __device__ __forceinline__ void stage_rc(int b, int& R, int& C) { const int st = b / 1024, sb = b % 1024, swz = sb ^ (((sb >> 9) & 1) << 5); R = (st >> 1) * 16 + swz / 64; C = (st & 1) * 32 + (swz % 64) / 2; }
__host__ __device__ __forceinline__ int perm32(int rho) { const int n = rho >> 4, i = rho & 15; return 8 * (i >> 2) + 4 * n + (i & 3); }

struct Unit { int pm, pn, koff, kp; };
struct Gemm { const bf16_t* A; const bf16_t* Bt; int M, N, K, ld; };

struct StaticOrder {
    int nM, nN, nwg, G, c;
    __host__ __device__ void init(int M, int N, int G_, int c_) { nM = M / BM; nN = N / BM; nwg = nM * nN; G = G_; c = c_; }
    __host__ __device__ bool next(int i, Unit& u) const {
        const long L = (long)i * G + c; if (L >= nwg) return false;
        int wgid = (int)L; { const int q = nwg / NXCD, r = nwg % NXCD, xcd = wgid % NXCD, off = wgid / NXCD; wgid = (xcd < r ? xcd * (q + 1) : r * (q + 1) + (xcd - r) * q) + off; }
        const int nig = WGM * nN, gid = wgid / nig, fm = gid * WGM, gsz = (nM - fm) < WGM ? (nM - fm) : WGM;
        u.pm = fm + ((wgid % nig) % gsz); u.pn = (wgid % nig) / gsz; u.koff = 0; u.kp = 0; return true;
    }
    __device__ __forceinline__ void a_ready(const Unit&) const {}
    __device__ __forceinline__ void done(const Unit&) const {}
};
__device__ __forceinline__ unsigned cvt_pk_bf16(float lo, float hi) { return ::pack2(lo, hi); }
__device__ __forceinline__ u32x4 pack8(f32x4 v0, f32x4 v1) { u32x4 w; w.x = cvt_pk_bf16(v0[0], v0[1]); w.y = cvt_pk_bf16(v0[2], v0[3]); w.z = cvt_pk_bf16(v1[0], v1[1]); w.w = cvt_pk_bf16(v1[2], v1[3]); return w; }
__device__ __forceinline__ void unpack8(u32x4 w, f32x4& v0, f32x4& v1) {
    v0[0] = __uint_as_float(w.x << 16); v0[1] = __uint_as_float(w.x & 0xffff0000u); v0[2] = __uint_as_float(w.y << 16); v0[3] = __uint_as_float(w.y & 0xffff0000u);
    v1[0] = __uint_as_float(w.z << 16); v1[1] = __uint_as_float(w.z & 0xffff0000u); v1[2] = __uint_as_float(w.w << 16); v1[3] = __uint_as_float(w.w & 0xffff0000u);
}
__device__ __forceinline__ float sigm(float x) { return __builtin_amdgcn_rcpf(1.0f + __expf(-x)); }
enum { EP_PROJ1 = 0, EP_SIGM = 1, EP_F32 = 2, EP_MERGE0 = 3, EP_MERGE1 = 4, EP_RES = 5, EP_SQRELU = 6, EP_PART = 7 };
struct Epi {
    static constexpr bool PERM = true, AFTER_DRAIN = false;
    int mode; int ldc; int goff; bf16_t* o; float* of32; const bf16_t* gate; bf16_t* uf; bf16_t* qkv; bf16_t* z; float* bd;
    __device__ __forceinline__ void operator()(const f32x4 (&acc)[2][2][4][2], const Unit& u, int wr, int wc, int fr, int fq) const {
        const int row0 = u.pm * BM + wr * 64 + fr, cl = wc * 32 + 8 * fq;
        if (mode == EP_RES) {
#pragma unroll
            for (int ai = 0; ai < 2; ++ai) {
                u32x4 l0[4][2];
#pragma unroll
                for (int m = 0; m < 4; ++m)
#pragma unroll
                    for (int bj = 0; bj < 2; ++bj) l0[m][bj] = *(const u32x4*)(o + (size_t)(row0 + ai * HALF + m * 16) * ldc + u.pn * BM + bj * HALF + cl);
#pragma unroll
                for (int m = 0; m < 4; ++m)
#pragma unroll
                    for (int bj = 0; bj < 2; ++bj) {
                        f32x4 v0 = acc[ai][bj][m][0], v1 = acc[ai][bj][m][1], p0, p1; unpack8(l0[m][bj], p0, p1);
                        v0 = v0 + p0 * 1.41421356237f; v1 = v1 + p1 * 1.41421356237f;
                        *(u32x4*)(o + (size_t)(row0 + ai * HALF + m * 16) * ldc + u.pn * BM + bj * HALF + cl) = pack8(v0, v1);
                    }
            }
            return;
        }
        if (mode == EP_MERGE0) {
#pragma unroll
            for (int ai = 0; ai < 2; ++ai) {
                u32x4 l0[4][2];
#pragma unroll
                for (int m = 0; m < 4; ++m)
#pragma unroll
                    for (int bj = 0; bj < 2; ++bj) l0[m][bj] = *(const u32x4*)(gate + (size_t)(row0 + ai * HALF + m * 16) * 2048 + u.pn * BM + bj * HALF + cl);
#pragma unroll
                for (int m = 0; m < 4; ++m)
#pragma unroll
                    for (int bj = 0; bj < 2; ++bj) {
                        f32x4 v0 = acc[ai][bj][m][0], v1 = acc[ai][bj][m][1], p0, p1; unpack8(l0[m][bj], p0, p1);
                        *(u32x4*)(o + (size_t)(row0 + ai * HALF + m * 16) * ldc + u.pn * BM + bj * HALF + cl) = pack8(v0 * p0, v1 * p1);
                    }
            }
            return;
        }
        if (mode == EP_MERGE1) {
#pragma unroll
            for (int ai = 0; ai < 2; ++ai)
#pragma unroll
                for (int mh = 0; mh < 2; ++mh) {
                    u32x4 l0[2][2], l1[2][2];
#pragma unroll
                    for (int m2 = 0; m2 < 2; ++m2)
#pragma unroll
                        for (int bj = 0; bj < 2; ++bj) {
                            const size_t row = (size_t)(row0 + ai * HALF + (mh * 2 + m2) * 16); const int col = u.pn * BM + bj * HALF + cl;
                            l0[m2][bj] = *(const u32x4*)(gate + row * 2048 + col);
                            l1[m2][bj] = (u32x4){0u, 0u, 0u, 0u};
                            if (mode == EP_MERGE1) l1[m2][bj] = *(const u32x4*)(o + row * ldc + col);
                        }
#pragma unroll
                    for (int m2 = 0; m2 < 2; ++m2)
#pragma unroll
                        for (int bj = 0; bj < 2; ++bj) {
                            const int m = mh * 2 + m2;
                            const size_t row = (size_t)(row0 + ai * HALF + m * 16); const int col = u.pn * BM + bj * HALF + cl;
                            f32x4 v0 = acc[ai][bj][m][0], v1 = acc[ai][bj][m][1], p0, p1, q0, q1; unpack8(l0[m2][bj], p0, p1); unpack8(l1[m2][bj], q0, q1);
                            v0 = v0 * p0 + q0; v1 = v1 * p1 + q1;
                            *(u32x4*)(o + row * ldc + col) = pack8(v0, v1);
                        }
                }
            return;
        }
#pragma unroll
        for (int ai = 0; ai < 2; ++ai)
#pragma unroll
            for (int m = 0; m < 4; ++m) {
                const size_t row = (size_t)(row0 + ai * HALF + m * 16);
#pragma unroll
                for (int bj = 0; bj < 2; ++bj) {
                    const int col = u.pn * BM + bj * HALF + cl;
                    f32x4 v0 = acc[ai][bj][m][0], v1 = acc[ai][bj][m][1];
                    if (mode == EP_PROJ1) {
                        if (u.pn < 2) { *(u32x4*)(uf + row * 512 + col) = pack8(v0, v1); }
                        else if (u.pn < 8) { *(u32x4*)(qkv + row * 1536 + (col - 512)) = pack8(v0, v1); }
                        else if (u.pn < 10) {
#pragma unroll
                            for (int e = 0; e < 4; ++e) { v0[e] = v0[e] * sigm(v0[e]); v1[e] = v1[e] * sigm(v1[e]); }
                            *(u32x4*)(z + row * 512 + (col - 2048)) = pack8(v0, v1);
                        } else { if (bj == 0 && wc == 0 && fq < 2) { float* d = bd + row * 16 + 8 * fq; *(f32x4*)d = v0; *(f32x4*)(d + 4) = v1; } }
                    } else if (mode == EP_SIGM) {
#pragma unroll
                        for (int e = 0; e < 4; ++e) { v0[e] = sigm(v0[e]); v1[e] = sigm(v1[e]); }
                        *(u32x4*)(o + row * ldc + col) = pack8(v0, v1);
                    } else if (mode == EP_F32) {
                        float* d = of32 + row * ldc + col; *(f32x4*)d = v0; *(f32x4*)(d + 4) = v1;
                    } else if (mode == EP_PART) {
                        float* d = of32 + ((size_t)u.kp * 512 + (row - (size_t)goff)) * 1024 + col; *(f32x4*)d = v0; *(f32x4*)(d + 4) = v1;
                    } else {
#pragma unroll
                        for (int e = 0; e < 4; ++e) { float a = v0[e] > 0.f ? v0[e] : 0.f, b = v1[e] > 0.f ? v1[e] : 0.f; v0[e] = a * a; v1[e] = b * b; }
                        *(u32x4*)(o + row * ldc + col) = pack8(v0, v1);
                    }
                }
            }
    }
};
struct Order {
    int nM, nN, nwg, G, c, swz, ks, kbytes, pm0;
    __device__ void init(int M, int N, int G_, int c_, int swz_) { nM = M / BM; nN = N / BM; nwg = nM * nN; G = G_; c = c_; swz = swz_; ks = 1; kbytes = 0; pm0 = 0; }
    __device__ void init_split(int ntile, int pm0_, int N, int ks_, int kbytes_, int G_, int c_) { nM = ntile; nN = N / BM; ks = ks_; kbytes = kbytes_; pm0 = pm0_; nwg = nM * nN * ks; G = G_; c = c_; swz = 2; }
    __device__ bool next(int i, Unit& u) const {
        const long L = (long)i * G + c; if (L >= nwg) return false;
        u.koff = 0; u.kp = 0;
        if (swz == 2) { const int l = (int)L; u.kp = l % ks; u.koff = u.kp * kbytes; const int r = l / ks; u.pn = r % nN; u.pm = pm0 + r / nN; return true; }
        if (!swz) { u.pm = (int)L % nM; u.pn = (int)L / nM; return true; }
        int wgid = (int)L; { const int q = nwg / NXCD, r = nwg % NXCD, xcd = wgid % NXCD, off = wgid / NXCD; wgid = (xcd < r ? xcd * (q + 1) : r * (q + 1) + (xcd - r) * q) + off; }
        const int nig = WGM * nN, gid = wgid / nig, fm = gid * WGM, gsz = (nM - fm) < WGM ? (nM - fm) : WGM;
        u.pm = fm + ((wgid % nig) % gsz); u.pn = (wgid % nig) / gsz; return true;
    }
    __device__ __forceinline__ void a_ready(const Unit&) const {}
    __device__ __forceinline__ void done(const Unit&) const {}
};
template <class Epi, class Sched, bool ALIGN_EPI = false, bool SP2 = false>
__device__ __forceinline__ void gemm_phase(PG8_LAS unsigned char* lds, const Gemm g, const Sched& S, const Epi& E) {
    const int tid = opaque_tid(), wid = __builtin_amdgcn_readfirstlane(tid >> 6), lane = tid & 63, wr = wid >> 2, wc = wid & 3, fr = lane & 15, fq = lane >> 4;
    const int K = g.K, nt = K / BK, LD = g.ld;
    unsigned voffA[2], voffB[2];
#pragma unroll
    for (int i = 0; i < 2; ++i) { int R, C; stage_rc(tid * 16 + i * 8192, R, C); const int Rb = Epi::PERM ? ((R & ~31) + perm32(R & 31)) : R;
        voffA[i] = (unsigned)(R * LD + C) * 2u; voffB[i] = (unsigned)(Rb * LD + C) * 2u; }
    const size_t kstep = (size_t)(BK * 2);
    const size_t hstep = (size_t)HALF * LD * 2;
    const size_t tstep = 2 * hstep;
    const unsigned ldsw = (unsigned)wid * 1024u;
    const int aoff = lds_byte(wr * 64 + fr, fq * 8), boff = lds_byte(wc * 32 + fr, fq * 8);
#define PG8_SA(b, h) (((b) * 2 + (h)) * HTB)
#define PG8_SB(b, h) ((4 + (b) * 2 + (h)) * HTB)
#define PG8_STAGE(bufoff, gbase, voff) do { _Pragma("unroll") for (int _i = 0; _i < 2; ++_i) \
        __builtin_amdgcn_global_load_lds((const unsigned*)((const char*)(gbase) + (voff)[_i]), (PG8_LAS unsigned*)(lds + (bufoff) + ldsw + _i * 8192), 16, 0, 0); } while (0)
#define PG8_LDA(dst, b, h) do { _Pragma("unroll") for (int m = 0; m < 4; ++m) _Pragma("unroll") for (int k = 0; k < 2; ++k) dst[m][k] = *(const PG8_LAS bf16x8*)(lds + PG8_SA(b, h) + aoff + m * 2048 + k * 1024); } while (0)
#define PG8_LDB(dst, b, h) do { _Pragma("unroll") for (int n = 0; n < 2; ++n) _Pragma("unroll") for (int k = 0; k < 2; ++k) dst[n][k] = *(const PG8_LAS bf16x8*)(lds + PG8_SB(b, h) + boff + n * 2048 + k * 1024); } while (0)
#define PG8_MMA(ai, bj, At, Bt) do { __builtin_amdgcn_s_setprio(1); _Pragma("unroll") for (int m = 0; m < 4; ++m) _Pragma("unroll") for (int n = 0; n < 2; ++n) _Pragma("unroll") for (int k = 0; k < 2; ++k) \
        acc[ai][bj][m][n] = __builtin_amdgcn_mfma_f32_16x16x32_bf16(Bt[n][k], At[m][k], acc[ai][bj][m][n], 0, 0, 0); __builtin_amdgcn_s_setprio(0); } while (0)
#define PG8_WAIT_V(n) asm volatile("s_waitcnt vmcnt(" #n ")" ::: "memory")
#define PG8_WAIT_L(n) asm volatile("s_waitcnt lgkmcnt(" #n ")" ::: "memory")
#define PG8_BAR __builtin_amdgcn_s_barrier()
#define PG8_SCHED __builtin_amdgcn_sched_barrier(0)
    Unit cur, nxt; int ui = 0;
    if (!S.next(0, cur)) return;
    f32x4 acc[2][2][4][2];
#pragma unroll
    for (int a = 0; a < 2; ++a)
#pragma unroll
        for (int b = 0; b < 2; ++b)
#pragma unroll
            for (int m = 0; m < 4; ++m)
#pragma unroll
                for (int n = 0; n < 2; ++n) acc[a][b][m][n] = (f32x4){0.f, 0.f, 0.f, 0.f};
    bf16x8 At[4][2], B0[2][2], B1[2][2];
    const char* cA = (const char*)g.A + (size_t)cur.pm * tstep + cur.koff; const char* cB = (const char*)g.Bt + (size_t)cur.pn * tstep + cur.koff;
    S.a_ready(cur);
    if constexpr (SP2) {
        PG8_STAGE(PG8_SB(0, 0), cB, voffB); PG8_STAGE(PG8_SB(0, 1), cB + hstep, voffB); PG8_STAGE(PG8_SA(0, 0), cA, voffA); PG8_STAGE(PG8_SA(0, 1), cA + hstep, voffA);
        if (wr == 1) PG8_BAR;
        PG8_WAIT_V(2); PG8_BAR;
        PG8_STAGE(PG8_SB(1, 0), cB + kstep, voffB); PG8_STAGE(PG8_SA(1, 0), cA + kstep, voffA); PG8_STAGE(PG8_SB(1, 1), cB + hstep + kstep, voffB);
        PG8_WAIT_V(6); PG8_BAR;
    } else {
        PG8_STAGE(PG8_SB(0, 0), cB, voffB); PG8_STAGE(PG8_SA(0, 0), cA, voffA); PG8_STAGE(PG8_SB(0, 1), cB + hstep, voffB); PG8_STAGE(PG8_SA(0, 1), cA + hstep, voffA);
        if (wr == 1) PG8_BAR;
        PG8_WAIT_V(4); PG8_BAR;
        PG8_STAGE(PG8_SB(1, 0), cB + kstep, voffB); PG8_STAGE(PG8_SA(1, 0), cA + kstep, voffA); PG8_STAGE(PG8_SB(1, 1), cB + hstep + kstep, voffB);
        PG8_WAIT_V(6); PG8_BAR;
    }
    for (;;) {
        const bool has_next = S.next(ui + 1, nxt);
        const char* nA = has_next ? (const char*)g.A + (size_t)nxt.pm * tstep + nxt.koff : cA; const char* nB = has_next ? (const char*)g.Bt + (size_t)nxt.pn * tstep + nxt.koff : cB;
        for (int t = 0; t < nt; t += 2) {
            const bool last = (t == nt - 2);
            const char* a1 = cA + (size_t)(t + 1) * kstep;
            const char* a2 = last ? nA : cA + (size_t)(t + 2) * kstep; const char* b2 = last ? nB : cB + (size_t)(t + 2) * kstep;
            const char* a3 = a2 + kstep; const char* b3 = b2 + kstep;
            if (last && has_next) S.a_ready(nxt);
            if constexpr (SP2) {
            PG8_LDB(B0, 0, 0); PG8_LDB(B1, 0, 1); PG8_SCHED; PG8_LDA(At, 0, 0); PG8_STAGE(PG8_SA(1, 1), a1 + hstep, voffA);
            PG8_WAIT_V(8); PG8_WAIT_L(0); PG8_BAR; PG8_MMA(0, 0, At, B0); PG8_MMA(0, 1, At, B1); PG8_BAR; PG8_SCHED;
            PG8_LDA(At, 0, 1); PG8_STAGE(PG8_SB(0, 0), b2, voffB); PG8_STAGE(PG8_SB(0, 1), b2 + hstep, voffB); PG8_STAGE(PG8_SA(0, 0), a2, voffA);
            PG8_WAIT_V(8); PG8_WAIT_L(0); PG8_BAR; PG8_MMA(1, 0, At, B0); PG8_MMA(1, 1, At, B1); PG8_BAR; PG8_SCHED;
            PG8_LDB(B0, 1, 0); PG8_LDB(B1, 1, 1); PG8_SCHED; PG8_LDA(At, 1, 0); PG8_STAGE(PG8_SA(0, 1), a2 + hstep, voffA);
            PG8_WAIT_V(8); PG8_WAIT_L(0); PG8_BAR; PG8_MMA(0, 0, At, B0); PG8_MMA(0, 1, At, B1); PG8_BAR; PG8_SCHED;
            PG8_LDA(At, 1, 1); PG8_STAGE(PG8_SB(1, 0), b3, voffB); PG8_STAGE(PG8_SB(1, 1), b3 + hstep, voffB); PG8_STAGE(PG8_SA(1, 0), a3, voffA);
            PG8_WAIT_V(8); PG8_WAIT_L(0); PG8_BAR; PG8_MMA(1, 0, At, B0); PG8_MMA(1, 1, At, B1); PG8_BAR; PG8_SCHED;
            } else {
            PG8_LDB(B0, 0, 0); PG8_SCHED; PG8_LDA(At, 0, 0); PG8_STAGE(PG8_SA(1, 1), a1 + hstep, voffA);
            PG8_WAIT_L(8); PG8_BAR; PG8_WAIT_L(0); PG8_MMA(0, 0, At, B0); PG8_BAR; PG8_SCHED;
            PG8_LDB(B1, 0, 1); PG8_STAGE(PG8_SB(0, 0), b2, voffB);
            PG8_BAR; PG8_WAIT_L(0); PG8_MMA(0, 1, At, B1); PG8_BAR;
            PG8_LDA(At, 0, 1); PG8_STAGE(PG8_SA(0, 0), a2, voffA);
            PG8_BAR; PG8_WAIT_L(0); PG8_MMA(1, 0, At, B0); PG8_BAR; PG8_SCHED;
            PG8_STAGE(PG8_SB(0, 1), b2 + hstep, voffB);
            PG8_WAIT_V(6); PG8_BAR; PG8_MMA(1, 1, At, B1); PG8_BAR;
            PG8_LDB(B0, 1, 0); PG8_SCHED; PG8_LDA(At, 1, 0); PG8_STAGE(PG8_SA(0, 1), a2 + hstep, voffA);
            PG8_WAIT_L(8); PG8_BAR; PG8_WAIT_L(0); PG8_MMA(0, 0, At, B0); PG8_BAR; PG8_SCHED;
            PG8_LDB(B1, 1, 1); PG8_STAGE(PG8_SB(1, 0), b3, voffB);
            PG8_BAR; PG8_WAIT_L(0); PG8_MMA(0, 1, At, B1); PG8_BAR;
            PG8_LDA(At, 1, 1); PG8_STAGE(PG8_SA(1, 0), a3, voffA);
            PG8_BAR; PG8_WAIT_L(0); PG8_MMA(1, 0, At, B0); PG8_BAR; PG8_SCHED;
            PG8_STAGE(PG8_SB(1, 1), b3 + hstep, voffB);
            PG8_WAIT_V(6); PG8_BAR; PG8_MMA(1, 1, At, B1); PG8_BAR;
            }
        }
        if constexpr (ALIGN_EPI) { if (wr == 0) PG8_BAR; }
        if constexpr (!Epi::AFTER_DRAIN) { E(acc, cur, wr, wc, fr, fq); S.done(cur); }
        if (!has_next) break;
#pragma unroll
        for (int a = 0; a < 2; ++a)
#pragma unroll
            for (int b = 0; b < 2; ++b)
#pragma unroll
                for (int m = 0; m < 4; ++m)
#pragma unroll
                    for (int n = 0; n < 2; ++n) acc[a][b][m][n] = (f32x4){0.f, 0.f, 0.f, 0.f};
        cur = nxt; cA = nA; cB = nB; ++ui;
        if constexpr (ALIGN_EPI) { if (wr == 1) PG8_BAR; }
    }
    PG8_WAIT_V(0);
    if constexpr (!ALIGN_EPI) { if (wr == 0) PG8_BAR; }
    PG8_BAR;
    if constexpr (Epi::AFTER_DRAIN) { E.fused(acc, cur, wr, wc, fr, fq, lds, wid, lane); S.done(cur); }
#undef PG8_SA
#undef PG8_SB
#undef PG8_STAGE
#undef PG8_LDA
#undef PG8_LDB
#undef PG8_MMA
#undef PG8_WAIT_V
#undef PG8_WAIT_L
#undef PG8_BAR
#undef PG8_SCHED
}
}
#define NT 512
__device__ __forceinline__ bf16x8 lds_frag(const LAS bf16* p) { return *(const LAS bf16x8*)p; }

template <int CTRL> __device__ __forceinline__ float dpp_f(float v) { return __int_as_float(__builtin_amdgcn_update_dpp(0, __float_as_int(v), CTRL, 0xf, 0xf, false)); }
__device__ __forceinline__ float rdlane(float v, int l) { return __int_as_float(__builtin_amdgcn_readlane(__float_as_int(v), l)); }
template <int CTRL, int RM> __device__ __forceinline__ float dpp_rm(float v) { return __int_as_float(__builtin_amdgcn_update_dpp(0, __float_as_int(v), CTRL, RM, 0xf, false)); }
__device__ __forceinline__ float wave_sum_dpp(float v) {
    v += dpp_f<0x128>(v); v += dpp_f<0x124>(v); v += dpp_f<0x122>(v); v += dpp_f<0x121>(v);
    v += dpp_rm<0x142, 0xa>(v);
    v += dpp_rm<0x143, 0xc>(v);
    return rdlane(v, 63);
}

__device__ __forceinline__ int win_src_col(int n) {
    if (n < 2048) return n;
    if (n < 2560) return 2064 + (n - 2048);
    if (n < 2576) return 2048 + (n - 2560);
    if (n < 2816) return -1;
    return 2576 + (n - 2816);
}
__device__ __forceinline__ void transpose_tile(LAS float* tile, const float* src, int ld_src, bf16* dst, int K, int n0, int k0, bool winmap) {
    const int tid = opaque_tid();
    float v[16];
#pragma unroll
    for (int e = 0; e < 16; ++e) {
        const int idx = tid + NT * e, kk = idx >> 6, nn = idx & 63;
        const int col = winmap ? win_src_col(n0 + nn) : (n0 + nn);
        v[e] = col >= 0 ? src[(size_t)(k0 + kk) * ld_src + col] : 0.f;
    }
#pragma unroll
    for (int e = 0; e < 16; ++e) { const int idx = tid + NT * e; tile[(idx >> 6) * 65 + (idx & 63)] = v[e]; }
    __syncthreads();
#pragma unroll
    for (int e = 0; e < 8; ++e) {
        const int idx = tid + NT * e, nn = idx >> 6, kk = (idx & 63) * 2;
        *(unsigned*)(dst + (size_t)(n0 + nn) * K + k0 + kk) = pack2(tile[kk * 65 + nn], tile[(kk + 1) * 65 + nn]);
    }
    __syncthreads();
}
__device__ __forceinline__ void ln_row_store(const float (&v)[16], const float (&g)[16], const float (&b)[16], int lane, bf16* orow, float* frow) {
    float s = 0.f;
#pragma unroll
    for (int e = 0; e < 16; ++e) s += v[e];
    const float mu = wave_sum_dpp(s) * (1.0f / 1024.0f);
    float q = 0.f;
#pragma unroll
    for (int e = 0; e < 16; ++e) { const float d = v[e] - mu; q += d * d; }
    const float rs = rsqrtf(wave_sum_dpp(q) * (1.0f / 1024.0f) + 1e-5f);
#pragma unroll
    for (int hh = 0; hh < 2; ++hh) {
        const int c0 = hh * 512 + 8 * lane;
        float y[8];
#pragma unroll
        for (int e = 0; e < 8; ++e) y[e] = (v[hh * 8 + e] - mu) * rs * g[hh * 8 + e] + b[hh * 8 + e];
        if (orow) { u32x4 w; w.x = pack2(y[0], y[1]); w.y = pack2(y[2], y[3]); w.z = pack2(y[4], y[5]); w.w = pack2(y[6], y[7]); *(u32x4*)(orow + c0) = w; }
        if (frow) { *(f32x4*)(frow + c0) = (f32x4){y[0], y[1], y[2], y[3]}; *(f32x4*)(frow + c0 + 4) = (f32x4){y[4], y[5], y[6], y[7]}; }
    }
}
__device__ __forceinline__ void load_gb(const float* g, const float* b, int lane, float (&gv)[16], float (&bv)[16]) {
#pragma unroll
    for (int hh = 0; hh < 2; ++hh)
#pragma unroll
        for (int q4 = 0; q4 < 2; ++q4) {
            const f32x4 a = *(const f32x4*)(g + hh * 512 + 8 * lane + 4 * q4), c = *(const f32x4*)(b + hh * 512 + 8 * lane + 4 * q4);
#pragma unroll
            for (int e = 0; e < 4; ++e) { gv[hh * 8 + q4 * 4 + e] = a[e]; bv[hh * 8 + q4 * 4 + e] = c[e]; }
        }
}

__device__ __forceinline__ void phase_prologue(LAS unsigned char* lds, const Params& p) {
    const int tid = opaque_tid(), lane = tid & 63, w = tid >> 6, G = gridDim.x, bx = blockIdx.x;
    unsigned char* ws = p.ws;
    LAS float* tile = (LAS float*)lds;
    for (int t = bx; t < 3648; t += G) {
        if (t < 1024) { const int l = t >> 9, r = t & 511, nt = r >> 3, kt = r & 7; transpose_tile(tile, p.w_up + (size_t)l * 1024 * 4096, 4096, (bf16*)(ws + WS_WUP) + (size_t)l * 4096 * 1024, 1024, nt * 64, kt * 128, false); }
        else if (t < 2048) { const int u = t - 1024, l = u >> 9, r = u & 511, nt = r >> 5, kt = r & 31; transpose_tile(tile, p.w_down + (size_t)l * 4096 * 1024, 1024, (bf16*)(ws + WS_WDN) + (size_t)l * 1024 * 4096, 4096, nt * 64, kt * 128, false); }
        else if (t < 2304) { const int u = t - 2048, l = u >> 7, r = u & 127, nt = r >> 3, kt = r & 7; transpose_tile(tile, p.w_out + (size_t)l * 1024 * 1024, 1024, (bf16*)(ws + WS_WOUT) + (size_t)l * 1024 * 1024, 1024, nt * 64, kt * 128, false); }
        else if (t < 2432) { const int u = t - 2304, l = u >> 6, r = u & 63, nt = r >> 2, kt = r & 3; transpose_tile(tile, p.w_fp + (size_t)l * 512 * 1024, 1024, (bf16*)(ws + WS_WFP) + (size_t)l * 1024 * 512, 512, nt * 64, kt * 128, false); }
        else if (t < 2560) { const int u = t - 2432, l = u >> 6, r = u & 63, nt = r >> 2, kt = r & 3; transpose_tile(tile, p.w_dp + (size_t)l * 512 * 1024, 1024, (bf16*)(ws + WS_WDP) + (size_t)l * 1024 * 512, 512, nt * 64, kt * 128, false); }
        else { const int u = t - 2560, l = u / 544, r = u % 544, nt = r >> 3, kt = r & 7; transpose_tile(tile, p.w_in + (size_t)l * 1024 * INW, INW, (bf16*)(ws + WS_WIN) + (size_t)l * NIN * 1024, 1024, 512 + nt * 64, kt * 128, true); }
    }
    {
        LAS float* tab = (LAS float*)lds;
        LAS float* inb = tab + 128;
        if (tid < 128) tab[tid] = cospif((float)tid * (1.0f / 64.0f));
        __syncthreads();
        for (int it = bx; it < 2 * 4 * 256; it += G) {
            const int l = it >> 10, g = (it >> 8) & 3, k0 = (it & 255) * 4;
            __syncthreads();
            { const int kk = tid >> 7, c = tid & 127; inb[kk * 128 + c] = p.w_in[(size_t)l * 1024 * INW + (size_t)(k0 + kk) * INW + g * 128 + c]; }
            __syncthreads();
            const int kk = tid >> 7, pos = tid & 127;
            const int f = pos <= 64 ? pos : pos - 64, sh = pos <= 64 ? 0 : 96;
            float s = 0.f;
#pragma unroll 8
            for (int c = 0; c < 128; ++c) s += inb[kk * 128 + c] * tab[(c * f + sh) & 127];
            ((bf16*)(ws + WS_WIN))[(size_t)l * NIN * 1024 + (size_t)(g * 128 + pos) * 1024 + k0 + kk] = f2bf(s);
        }
        __syncthreads();
    }
    {
        float gv[16], bv[16]; load_gb(p.ln0g, p.ln0b, lane, gv, bv);
        for (int r0 = (bx * 8 + w) * 2; r0 < NROWS; r0 += G * 16) {
            float v[2][16]; bool pad[2];
#pragma unroll
            for (int k = 0; k < 2; ++k) {
                const int r = r0 + k; int b, pp; pos_of(r, b, pp); pad[k] = pp < PADR;
                const float* src = pp < 64 ? p.meta + (size_t)(pp < PADR ? 0 : pp - PADR) * 1024 : p.x + ((size_t)b * SEQ + (pp - 64)) * 1024;
#pragma unroll
                for (int hh = 0; hh < 2; ++hh) { const f32x4 a = *(const f32x4*)(src + hh * 512 + 8 * lane), c = *(const f32x4*)(src + hh * 512 + 8 * lane + 4);
#pragma unroll
                    for (int e = 0; e < 4; ++e) { v[k][hh * 8 + e] = a[e]; v[k][hh * 8 + 4 + e] = c[e]; } }
            }
#pragma unroll
            for (int k = 0; k < 2; ++k) {
                bf16* orow = (bf16*)(ws + WS_XB) + (size_t)(r0 + k) * 1024;
                if (pad[k]) { *(u32x4*)(orow + 8 * lane) = (u32x4){0u, 0u, 0u, 0u}; *(u32x4*)(orow + 512 + 8 * lane) = (u32x4){0u, 0u, 0u, 0u}; }
                else ln_row_store(v[k], gv, bv, lane, orow, nullptr);
            }
        }
    }
    {
        __syncthreads();
        LAS float* tab = (LAS float*)lds;
        for (int m = tid; m < LTOK; m += NT) tab[m] = cospif((float)m * (1.0f / 2056.0f));
        __syncthreads();
        bf16* Cm = (bf16*)(ws + WS_CM); bf16* Sm = (bf16*)(ws + WS_SM);
        const int total = 2 * DFT_M * (DFT_K / 2);
        for (int i = bx * NT + tid; i < total; i += G * NT) {
            const int par = i / (DFT_M * (DFT_K / 2)), rem = i % (DFT_M * (DFT_K / 2)), l = rem / (DFT_K / 2), k = (rem % (DFT_K / 2)) * 2;
            float c0 = 0.f, s0 = 0.f, c1 = 0.f, s1 = 0.f;
            if (l <= HALF_L / 2) {
                const int j0 = 2 * k + par, j1 = 2 * (k + 1) + par;
                if (j0 <= HALF_L) { const int m = (l * j0) % LTOK, ms = m >= 1028 ? m - 1028 : m + 3084; c0 = tab[m]; s0 = tab[ms]; }
                if (j1 <= HALF_L) { const int m = (l * j1) % LTOK, ms = m >= 1028 ? m - 1028 : m + 3084; c1 = tab[m]; s1 = tab[ms]; }
            }
            *(unsigned*)(Cm + ((size_t)par * DFT_M + l) * DFT_K + k) = pack2(c0, c1);
            *(unsigned*)(Sm + ((size_t)par * DFT_M + l) * DFT_K + k) = pack2(s0, s1);
        }
        __syncthreads();
    }
}

__device__ __forceinline__ void phase_fold(LAS unsigned char* lds, const Params& p) {
    const int tid = opaque_tid(), G = gridDim.x, bx = blockIdx.x;
    const bf16* UF = (const bf16*)(p.ws + WS_UF); bf16* EcT = (bf16*)(p.ws + WS_ECT); bf16* EsT = (bf16*)(p.ws + WS_EST);
    LAS float* tile = (LAS float*)lds;
    for (int it = bx; it < 32 * 36; it += G) {
        const int bg = it / 36, jt = it % 36, b = bg >> 2, g = bg & 3, j0 = jt * 64;
        bf16 u1[16], u2[16];
#pragma unroll
        for (int e = 0; e < 16; ++e) {
            const int idx = tid + NT * e, jj = idx >> 7, pos = idx & 127, j = j0 + jj;
            const int ja = j <= HALF_L ? j : 0, jb = (j > 0 && j < HALF_L) ? LTOK - j : ja;
            u1[e] = UF[(size_t)row_of(b, PADR + ja) * 512 + g * 128 + pos];
            u2[e] = UF[(size_t)row_of(b, PADR + jb) * 512 + g * 128 + pos];
        }
#pragma unroll
        for (int e = 0; e < 16; ++e) {
            const int idx = tid + NT * e, jj = idx >> 7, pos = idx & 127, j = j0 + jj;
            float val = 0.f;
            if (j <= HALF_L) {
                const float a = bf2f(u1[e]), c = bf2f(u2[e]);
                if (j == 0 || j == HALF_L) val = pos <= 64 ? a : 0.f;
                else val = pos <= 64 ? a + c : a - c;
            }
            tile[jj * 129 + pos] = val;
        }
        __syncthreads();
#pragma unroll
        for (int e = 0; e < 16; ++e) {
            const int idx = tid + NT * e, pos = idx >> 6, jj = idx & 63;
            const float v = tile[jj * 129 + pos];
            const int j = j0 + jj, par = j & 1, k = j >> 1;
            if (pos <= 64) EcT[((size_t)par * DFT_NC + bg * 65 + pos) * DFT_K + k] = f2bf(v);
            else EsT[((size_t)par * DFT_NS + bg * 63 + pos - 65) * DFT_K + k] = f2bf(v);
        }
        __syncthreads();
    }
    for (int par = 0; par < 2; ++par) {
        for (int i = bx * NT + tid; i < 224 * (DFT_K / 2); i += G * NT) ((unsigned*)(EcT + ((size_t)par * DFT_NC + 2080) * DFT_K))[i] = 0u;
        for (int i = bx * NT + tid; i < 32 * (DFT_K / 2); i += G * NT) ((unsigned*)(EsT + ((size_t)par * DFT_NS + 2016) * DFT_K))[i] = 0u;
    }
}

__device__ __forceinline__ void phase_unfold(LAS unsigned char* lds, const Params& p) {
    const int tid = opaque_tid(), lane = tid & 63, w = tid >> 6, G = gridDim.x, bx = blockIdx.x;
    const float* P = (const float*)(p.ws + WS_P); const float* Q = (const float*)(p.ws + WS_Q); bf16* FM = (bf16*)(p.ws + WS_UF);
    const float scale = 1.0f / sqrtf((float)LTOK * 128.0f);
    const int g = lane >> 4, cb = (8 * lane) & 127;
    LAS float* strip = (LAS float*)lds + w * (4 * 4 * 264);
    for (int r0 = (bx * 8 + w) * 4; r0 < NROWS; r0 += G * 32) {
        float sg[4]; bool pad[4], hi[4];
#pragma unroll
        for (int k = 0; k < 4; ++k) {
            const int r = r0 + k; int b, pp; pos_of(r, b, pp); pad[k] = pp < PADR;
            const int l = pad[k] ? 0 : pp - PADR, lf = l <= HALF_L ? l : LTOK - l; sg[k] = l <= HALF_L ? 1.f : -1.f;
            hi[k] = lf > HALF_L / 2; const int lh = hi[k] ? HALF_L - lf : lf;
            const float* Pe = P + (size_t)lh * DFT_NC + b * 260; const float* Po = Pe + (size_t)DFT_M * DFT_NC;
            const float* Qe = Q + (size_t)lh * DFT_NS + b * 252; const float* Qo = Qe + (size_t)DFT_M * DFT_NS;
            float va[5], vb[5], vc[4], vd[4];
#pragma unroll
            for (int q = 0; q < 5; ++q) { const int i = q * 64 + lane; va[q] = i < 260 ? Pe[i] : 0.f; vb[q] = i < 260 ? Po[i] : 0.f; }
#pragma unroll
            for (int q = 0; q < 4; ++q) { const int i = q * 64 + lane; vc[q] = i < 252 ? Qe[i] : 0.f; vd[q] = i < 252 ? Qo[i] : 0.f; }
            LAS float* sk = strip + k * (4 * 264);
#pragma unroll
            for (int q = 0; q < 5; ++q) { const int i = q * 64 + lane; if (i < 264) { sk[i] = va[q]; sk[264 + i] = vb[q]; } }
#pragma unroll
            for (int q = 0; q < 4; ++q) { const int i = q * 64 + lane; sk[528 + i] = vc[q]; sk[792 + i] = vd[q]; }
        }
        asm volatile("s_waitcnt lgkmcnt(0)" ::: "memory");
#pragma unroll
        for (int k = 0; k < 4; ++k) {
            const LAS float* sk = strip + k * (4 * 264);
            const float so = hi[k] ? -1.f : 1.f;
            bf16* orow = FM + (size_t)(r0 + k) * 512 + 8 * lane;
            float y[8];
#pragma unroll
            for (int e = 0; e < 8; ++e) {
                const int cp = cb + e, c = cp <= 64 ? cp : 128 - cp;
                const float pv = sk[g * 65 + c] + so * sk[264 + g * 65 + c];
                float qv = 0.f;
                if (c >= 1 && c <= 63) { const float qe = sk[528 + g * 63 + c - 1], qo = sk[792 + g * 63 + c - 1]; qv = hi[k] ? qo - qe : qe + qo; }
                y[e] = pad[k] ? 0.f : (cp <= 64 ? pv - sg[k] * qv : pv + sg[k] * qv) * scale;
            }
            u32x4 wv; wv.x = pack2(y[0], y[1]); wv.y = pack2(y[2], y[3]); wv.z = pack2(y[4], y[5]); wv.w = pack2(y[6], y[7]); *(u32x4*)orow = wv;
        }
        asm volatile("s_waitcnt lgkmcnt(0)" ::: "memory");
    }
}

__device__ __forceinline__ void phase_combine(const Params& p, int layer, int first_wg, int nwg, int nrows) {
    const int tid = opaque_tid(), lane = tid & 63, w = tid >> 6, G = nwg, bx = (int)blockIdx.x - first_wg;
    if (bx < 0) return;
    bf16* OF = (bf16*)(p.ws + WS_OF); const bf16* OB = (const bf16*)(p.ws + WS_OB); const bf16* Z = (const bf16*)(p.ws + WS_Z);
    const float* ng = p.dng + layer * 128 + ((8 * lane) & 127);
    float gv[8];
#pragma unroll
    for (int e = 0; e < 8; ++e) gv[e] = ng[e];
    for (int r0 = (bx * 8 + w) * 4; r0 < nrows; r0 += G * 32) {
        u32x4 ua[4], ub[4], uz[4];
#pragma unroll
        for (int k = 0; k < 4; ++k) { const size_t off = (size_t)(r0 + k) * 512 + 8 * lane; ua[k] = *(const u32x4*)(OF + off); ub[k] = *(const u32x4*)(OB + off); uz[k] = *(const u32x4*)(Z + off); }
#pragma unroll
        for (int k = 0; k < 4; ++k) {
            const size_t off = (size_t)(r0 + k) * 512 + 8 * lane;
            f32x4 a0, a1, b0, b1, z0, z1;
            pg8::unpack8(ua[k], a0, a1); pg8::unpack8(ub[k], b0, b1); pg8::unpack8(uz[k], z0, z1);
            a0 = a0 + b0; a1 = a1 + b1;
            float ss = a0[0] * a0[0] + a0[1] * a0[1] + a0[2] * a0[2] + a0[3] * a0[3] + a1[0] * a1[0] + a1[1] * a1[1] + a1[2] * a1[2] + a1[3] * a1[3];
            ss += dpp_f<0x128>(ss); ss += dpp_f<0x124>(ss); ss += dpp_f<0x122>(ss); ss += dpp_f<0x121>(ss);
            const float rn = rsqrtf(ss * (1.0f / 128.0f) + 1e-6f);
            float y[8];
#pragma unroll
            for (int e = 0; e < 4; ++e) { y[e] = a0[e] * rn * gv[e] * z0[e]; y[4 + e] = a1[e] * rn * gv[4 + e] * z1[e]; }
            u32x4 wv; wv.x = pack2(y[0], y[1]); wv.y = pack2(y[2], y[3]); wv.z = pack2(y[4], y[5]); wv.w = pack2(y[6], y[7]); *(u32x4*)(OF + off) = wv;
        }
    }
}

__device__ __forceinline__ void phase_ln(const Params& p, const float* g, const float* b, bool final_, const float* T, int nparts, int nrows) {
    const int tid = opaque_tid(), lane = tid & 63, w = tid >> 6, G = gridDim.x, bx = blockIdx.x;
    bf16* XB = (bf16*)(p.ws + WS_XB);
    float gv[16], bv[16]; load_gb(g, b, lane, gv, bv);
    for (int r0 = (bx * 8 + w) * 8; r0 < NMAIN; r0 += G * 64) {
        u32x4 u0[8], u1[8];
#pragma unroll
        for (int k = 0; k < 8; ++k) { bf16* row = XB + (size_t)(r0 + k) * 1024; u0[k] = *(const u32x4*)(row + 8 * lane); u1[k] = *(const u32x4*)(row + 512 + 8 * lane); }
#pragma unroll
        for (int k = 0; k < 8; ++k) {
            const int r = r0 + k;
            bf16* row = XB + (size_t)r * 1024;
            f32x4 a0, a1, c0, c1;
            pg8::unpack8(u0[k], a0, a1); pg8::unpack8(u1[k], c0, c1);
            float v[16];
#pragma unroll
            for (int e = 0; e < 4; ++e) { v[e] = a0[e]; v[4 + e] = a1[e]; v[8 + e] = c0[e]; v[12 + e] = c1[e]; }
            ln_row_store(v, gv, bv, lane, final_ ? nullptr : row, final_ ? p.out + (size_t)r * 1024 : nullptr);
        }
    }
    for (int r = NMAIN + bx * 8 + w; r < nrows; r += G * 8) {
        bf16* row = XB + (size_t)r * 1024;
        f32x4 a0, a1, c0, c1;
        pg8::unpack8(*(const u32x4*)(row + 8 * lane), a0, a1); pg8::unpack8(*(const u32x4*)(row + 512 + 8 * lane), c0, c1);
        float v[16];
#pragma unroll
        for (int e = 0; e < 4; ++e) { v[e] = a0[e]; v[4 + e] = a1[e]; v[8 + e] = c0[e]; v[12 + e] = c1[e]; }
        if (T != nullptr) {
            float acc[16];
#pragma unroll
            for (int e = 0; e < 16; ++e) acc[e] = 0.f;
            for (int pt0 = 0; pt0 < nparts; pt0 += 4) {
                f32x4 x[4][4];
#pragma unroll
                for (int q = 0; q < 4; ++q) {
                    const float* tp = T + ((size_t)(pt0 + q) * 512 + (r - NMAIN)) * 1024;
#pragma unroll
                    for (int hh = 0; hh < 2; ++hh) { x[q][hh * 2] = *(const f32x4*)(tp + hh * 512 + 8 * lane); x[q][hh * 2 + 1] = *(const f32x4*)(tp + hh * 512 + 8 * lane + 4); }
                }
#pragma unroll
                for (int q = 0; q < 4; ++q)
#pragma unroll
                    for (int hh = 0; hh < 2; ++hh)
#pragma unroll
                        for (int e = 0; e < 4; ++e) { acc[hh * 8 + e] += x[q][hh * 2][e]; acc[hh * 8 + 4 + e] += x[q][hh * 2 + 1][e]; }
            }
#pragma unroll
            for (int e = 0; e < 16; ++e) v[e] = ALPHA * v[e] + acc[e];
        }
        ln_row_store(v, gv, bv, lane, final_ ? nullptr : row, nullptr);
    }
}
constexpr int L_KS = 0, L_QS = 17408, L_VBT = 34816, L_KBET = 53248, L_KTT = 71680, L_ATT = 90112, L_TS = 99328, L_LM = 108544, L_TF = 126976;
constexpr int KP = 136, TP = 72;

__device__ __forceinline__ f32x4 mma16(const LAS bf16* A, int lda, const LAS bf16* Bt, int ldb, int ksteps, int lane, f32x4 acc) {
    const int l15 = lane & 15, quad = lane >> 4;
    const LAS bf16* ap = A + l15 * lda + quad * 8; const LAS bf16* bp = Bt + l15 * ldb + quad * 8;
    for (int ks = 0; ks < ksteps; ++ks) acc = __builtin_amdgcn_mfma_f32_16x16x32_bf16(lds_frag(ap + 32 * ks), lds_frag(bp + 32 * ks), acc, 0, 0, 0);
    return acc;
}

__device__ __forceinline__ int seg_start(int s) { return 16 * s; }

typedef float f32x2v __attribute__((ext_vector_type(2)));
struct D2Pre { unsigned xu[3][12]; float cw[3][5][2]; float bl, dl; };
__device__ __forceinline__ void d2_prefetch(D2Pre& r, const Params& p, int layer, int dir, int b, int h, int n, int w, int lane) {
    const int cn = dir ? 64 - n : n;
    const unsigned char* BD = p.ws + WS_BD + (size_t)row_of(b, 64 * cn) * 64 + (dir * 4 + h) * 4;
    const unsigned oboff = (unsigned)(dir ? 63 - lane : lane) * 64u;
    r.bl = *(const float*)(BD + (size_t)oboff); r.dl = *(const float*)(BD + 32 + (size_t)oboff);
    const unsigned l4 = (unsigned)lane * 4u, l8 = (unsigned)lane * 8u;
#pragma unroll
    for (int j = 0; j < 5; ++j) {
        const unsigned char* cp = (const unsigned char*)(p.conv_w + (size_t)(layer * 5 + j) * 1536 + h * 128);
#pragma unroll
        for (int t = 0; t < 3; ++t) { const f32x2v v = *(const f32x2v*)(cp + t * 2048 + (size_t)l8); r.cw[t][j][0] = v.x; r.cw[t][j][1] = v.y; }
    }
    const int pp0 = 64 * cn + 8 * w - 2;
    if (cn >= 2 && cn <= 63) {
        const unsigned char* rp = p.ws + WS_QKV + ((size_t)row_of(b, pp0) * 1536 + h * 128) * 2;
#pragma unroll
        for (int rr = 0; rr < 12; ++rr) {
            const unsigned ro = l4 + (unsigned)rr * 3072u;
#pragma unroll
            for (int t = 0; t < 3; ++t) r.xu[t][rr] = *(const unsigned*)(rp + t * 1024 + (size_t)ro);
        }
    } else {
#pragma unroll
        for (int rr = 0; rr < 12; ++rr) {
            const int pp = pp0 + rr;
#pragma unroll
            for (int t = 0; t < 3; ++t) {
                unsigned u = 0u;
                if (pp >= PADR && pp < LPAD) { const unsigned char* rp = p.ws + WS_QKV + ((size_t)row_of(b, pp) * 1536 + t * 512 + h * 128) * 2; u = *(const unsigned*)(rp + (size_t)l4); }
                r.xu[t][rr] = u;
            }
        }
    }
}
__device__ __forceinline__ u32x4 pack8dir(const float (&v)[8], int dir) {
    u32x4 a;
    if (dir) { a.x = pack2(v[7], v[6]); a.y = pack2(v[5], v[4]); a.z = pack2(v[3], v[2]); a.w = pack2(v[1], v[0]); }
    else { a.x = pack2(v[0], v[1]); a.y = pack2(v[2], v[3]); a.z = pack2(v[4], v[5]); a.w = pack2(v[6], v[7]); }
    return a;
}

__device__ __forceinline__ f32x4 bf4_to_f32(u32x2 v) { return (f32x4){__uint_as_float(v.x << 16), __uint_as_float(v.x & 0xffff0000u), __uint_as_float(v.y << 16), __uint_as_float(v.y & 0xffff0000u)}; }
template <int KS> __device__ __forceinline__ void ldfr(bf16x8 (&f)[KS], const LAS bf16* rowtile, int pitch, int lane) {
    const LAS bf16* q = rowtile + (lane & 15) * pitch + (lane >> 4) * 8;
#pragma unroll
    for (int ks = 0; ks < KS; ++ks) f[ks] = lds_frag(q + 32 * ks);
}
template <int KS> __device__ __forceinline__ f32x4 mmaf(const bf16x8 (&a)[KS], const bf16x8 (&b)[KS], f32x4 acc) {
#pragma unroll
    for (int ks = 0; ks < KS; ++ks) acc = __builtin_amdgcn_mfma_f32_16x16x32_bf16(a[ks], b[ks], acc, 0, 0, 0);
    return acc;
}
constexpr int L_GS = 145408, L_BS = 145664, L_ES = 145920;

__device__ __forceinline__ void d2_item(LAS unsigned char* lds, const Params& p, int layer, int dir, int b, int h, int n, unsigned char* slot, D2Pre& pre,
                                        bool has_next, int ndir, int nb, int nh, int nn) {
    const int tid = opaque_tid(), lane = tid & 63, w = __builtin_amdgcn_readfirstlane(tid >> 6), quad = lane >> 4, l15 = lane & 15;
    LAS bf16* kS = (LAS bf16*)(lds + L_KS); LAS bf16* qS = (LAS bf16*)(lds + L_QS); LAS bf16* vbT = (LAS bf16*)(lds + L_VBT); LAS bf16* kbeT = (LAS bf16*)(lds + L_KBET);
    LAS bf16* ktT = (LAS bf16*)(lds + L_KTT); LAS bf16* attS = (LAS bf16*)(lds + L_ATT); LAS bf16* TS = (LAS bf16*)(lds + L_TS);
    LAS float* Lm = (LAS float*)(lds + L_LM); LAS float* Tf = (LAS float*)(lds + L_TF);
    LAS bf16* valT = (LAS bf16*)(lds + L_LM); LAS bf16* kcdT = (LAS bf16*)(lds + L_TF);
    LAS float* gS = (LAS float*)(lds + L_GS); LAS float* bS = (LAS float*)(lds + L_BS); LAS float* eS = (LAS float*)(lds + L_ES);
    const int cn = dir ? 64 - n : n;
    float beta_l, gc_l, glast;
    {
        const int oi = dir ? 63 - lane : lane; const bool valid = (64 * cn + oi) >= PADR;
        beta_l = valid ? sigmoidf_(pre.bl) : 0.f;
        const float xx = pre.dl + p.dt_bias[layer * 8 + dir * 4 + h];
        const float sp = xx > 15.f ? xx : __logf(1.0f + __expf(xx));
        float g = valid ? -__expf(p.a_log[layer * 8 + dir * 4 + h]) * sp : 0.f;
        { float t;
          t = __int_as_float(__builtin_amdgcn_update_dpp(0, __float_as_int(g), 0x111, 0xf, 0xf, true)); g += t;
          t = __int_as_float(__builtin_amdgcn_update_dpp(0, __float_as_int(g), 0x112, 0xf, 0xf, true)); g += t;
          t = __int_as_float(__builtin_amdgcn_update_dpp(0, __float_as_int(g), 0x114, 0xf, 0xf, true)); g += t;
          t = __int_as_float(__builtin_amdgcn_update_dpp(0, __float_as_int(g), 0x118, 0xf, 0xf, true)); g += t;
          const float r0 = rdlane(g, 15), r1 = rdlane(g, 31), r2 = rdlane(g, 47);
          const int row = lane >> 4;
          g += (row >= 1 ? r0 : 0.f) + (row >= 2 ? r1 : 0.f) + (row >= 3 ? r2 : 0.f); }
        gc_l = g; glast = rdlane(g, 63);
        if (w == 0) { gS[lane] = gc_l; bS[lane] = beta_l; eS[lane] = __expf(gc_l); }
    }
#ifndef EXP
#define EXP 0
#endif
#pragma unroll 1
    for (int repB = 0; repB < (EXP == 9 ? 2 : 1); ++repB) {
        const int i0 = dir ? 56 - 8 * w : 8 * w;
        const int npad = cn == 0 ? (PADR - 8 * w) : 0;
#pragma unroll
        for (int t = 0; t < 3; ++t) {
            f32x2v xv[12], cwv[5], y[8];
#pragma unroll
            for (int rr = 0; rr < 12; ++rr) { const unsigned u = pre.xu[t][rr]; xv[rr] = (f32x2v){__uint_as_float(u << 16), __uint_as_float(u & 0xffff0000u)}; }
#pragma unroll
            for (int j = 0; j < 5; ++j) cwv[j] = (f32x2v){pre.cw[t][j][0], pre.cw[t][j][1]};
#pragma unroll
            for (int tt = 0; tt < 8; ++tt) {
                f32x2v a = cwv[0] * xv[tt];
#pragma unroll
                for (int j = 1; j < 5; ++j) a = cwv[j] * xv[tt + j] + a;
                const f32x2v s = a * (-1.4426950408889634f);
                f32x2v e; e.x = __builtin_amdgcn_exp2f(s.x); e.y = __builtin_amdgcn_exp2f(s.y);
                e = e + 1.0f;
                f32x2v r; r.x = __builtin_amdgcn_rcpf(e.x); r.y = __builtin_amdgcn_rcpf(e.y);
                y[tt] = a * r;
            }
            if (npad > 0) {
#pragma unroll
                for (int tt = 0; tt < 8; ++tt) if (tt < npad) y[tt] = (f32x2v){0.f, 0.f};
            }
            if (t == 0) {
#pragma unroll
                for (int tt = 0; tt < 8; ++tt) {
                    const int oi = 8 * w + tt, i = dir ? 63 - oi : oi;
                    const f32x2v sq = y[tt] * y[tt];
                    const float rn = rsqrtf(wave_sum_dpp(sq.x + sq.y) + 1e-6f) * 0.08838834764831845f;
                    const f32x2v q = y[tt] * rn;
                    *(LAS unsigned*)(qS + i * KP + 2 * lane) = pack2(q.x, q.y);
                }
            } else if (t == 1) {
                float o0[8], o1[8], p0[8], p1[8];
#pragma unroll
                for (int tt = 0; tt < 8; ++tt) {
                    const int oi = 8 * w + tt, i = dir ? 63 - oi : oi;
                    const float bi = rdlane(beta_l, i), gci = rdlane(gc_l, i);
                    const f32x2v sq = y[tt] * y[tt];
                    const float rn = rsqrtf(wave_sum_dpp(sq.x + sq.y) + 1e-6f);
                    const f32x2v k = y[tt] * rn;
                    *(LAS unsigned*)(kS + i * KP + 2 * lane) = pack2(k.x, k.y);
                    const float e1 = bi * __expf(gci), e2 = __expf(glast - gci);
                    const f32x2v ka = k * e1, kb = k * e2;
                    o0[tt] = ka.x; o1[tt] = ka.y; p0[tt] = kb.x; p1[tt] = kb.y;
                }
                *(LAS u32x4*)(kbeT + (2 * lane) * TP + i0) = pack8dir(o0, dir); *(LAS u32x4*)(kbeT + (2 * lane + 1) * TP + i0) = pack8dir(o1, dir);
                *(LAS u32x4*)(ktT + (2 * lane) * TP + i0) = pack8dir(p0, dir); *(LAS u32x4*)(ktT + (2 * lane + 1) * TP + i0) = pack8dir(p1, dir);
            } else {
                float o0[8], o1[8];
#pragma unroll
                for (int tt = 0; tt < 8; ++tt) {
                    const int oi = 8 * w + tt, i = dir ? 63 - oi : oi;
                    const f32x2v vb = y[tt] * rdlane(beta_l, i);
                    o0[tt] = vb.x; o1[tt] = vb.y;
                }
                *(LAS u32x4*)(vbT + (2 * lane) * TP + i0) = pack8dir(o0, dir); *(LAS u32x4*)(vbT + (2 * lane + 1) * TP + i0) = pack8dir(o1, dir);
            }
        }
    }
    lds_barrier();
    if (has_next) d2_prefetch(pre, p, layer, ndir, nb, nh, nn, w, lane);
#pragma unroll 1
    for (int repC = 0; repC < (EXP == 12 ? 2 : 1); ++repC) {
        const int mat = w >> 2, tr = w & 3;
        bf16x8 a[4], bq[4][4];
        ldfr<4>(a, (mat ? qS : kS) + 16 * tr * KP, KP, lane);
#pragma unroll
        for (int tc = 0; tc < 4; ++tc) if (tc <= tr) ldfr<4>(bq[tc], kS + 16 * tc * KP, KP, lane);
        const f32x4 g4 = *(const LAS f32x4*)(gS + 16 * tr + 4 * quad), b4 = *(const LAS f32x4*)(bS + 16 * tr + 4 * quad);
        float gcc[4];
#pragma unroll
        for (int tc = 0; tc < 4; ++tc) gcc[tc] = gS[16 * tc + l15];
#pragma unroll
        for (int tc = 0; tc < 4; ++tc) {
            f32x4 acc = (f32x4){0.f, 0.f, 0.f, 0.f};
            if (tc <= tr) acc = mmaf<4>(a, bq[tc], acc);
            const int c = 16 * tc + l15;
#pragma unroll
            for (int j = 0; j < 4; ++j) {
                const int i = 16 * tr + quad * 4 + j;
                const float dec = __expf(fminf(g4[j] - gcc[tc], 0.f));
                if (mat == 0) Lm[i * TP + c] = (i > c) ? b4[j] * acc[j] * dec : 0.f;
                else attS[i * TP + c] = (i >= c) ? f2bf(acc[j] * dec) : (bf16)0;
            }
        }
    }
    lds_barrier();
    if (w == 0) {
        const int blk = lane >> 4, c = lane & 15;
        const LAS float* Lb = Lm + (blk * 16) * TP + blk * 16;
        float t[16];
        t[0] = (c == 0) ? 1.f : 0.f;
        {
            f32x4 L4[8][2];
#pragma unroll
            for (int i = 1; i <= 8; ++i) { L4[i - 1][0] = *(const LAS f32x4*)(Lb + i * TP); L4[i - 1][1] = *(const LAS f32x4*)(Lb + i * TP + 4); }
#pragma unroll
            for (int i = 1; i <= 8; ++i) {
                float s0 = (i == c) ? 1.f : 0.f, s1 = 0.f;
#pragma unroll
                for (int j = 0; j < i; ++j) { const float lv = L4[i - 1][j >> 2][j & 3]; if (j & 1) s1 -= lv * t[j]; else s0 -= lv * t[j]; }
                t[i] = s0 + s1;
            }
        }
        {
            f32x4 L4[7][4];
#pragma unroll
            for (int i = 9; i <= 15; ++i)
#pragma unroll
                for (int q4 = 0; q4 < 4; ++q4) L4[i - 9][q4] = *(const LAS f32x4*)(Lb + i * TP + 4 * q4);
#pragma unroll
            for (int i = 9; i <= 15; ++i) {
                float s0 = (i == c) ? 1.f : 0.f, s1 = 0.f;
#pragma unroll
                for (int j = 0; j < i; ++j) { const float lv = L4[i - 9][j >> 2][j & 3]; if (j & 1) s1 -= lv * t[j]; else s0 -= lv * t[j]; }
                t[i] = s0 + s1;
            }
        }
#pragma unroll
        for (int i = 0; i < 16; ++i) { Tf[(blk * 16 + i) * TP + blk * 16 + c] = t[i]; TS[(blk * 16 + i) * TP + blk * 16 + c] = f2bf(t[i]); }
    } else {
        for (int idx = tid - 64; idx < 6 * 256; idx += NT - 64) {
            const int bk = idx >> 8, e = idx & 255, br = bk < 3 ? 0 : (bk < 5 ? 1 : 2), bc = bk < 3 ? bk + 1 : (bk < 5 ? bk - 1 : 3);
            Tf[(br * 16 + (e >> 4)) * TP + bc * 16 + (e & 15)] = 0.f; TS[(br * 16 + (e >> 4)) * TP + bc * 16 + (e & 15)] = (bf16)0;
        }
    }
    lds_barrier();
    {
        const int base = (tid >> 8) * 32, i = (tid >> 4) & 15, c = tid & 15;
        f32x4 a4[4]; float bv[16];
#pragma unroll
        for (int q4 = 0; q4 < 4; ++q4) a4[q4] = *(const LAS f32x4*)(Lm + (base + 16 + i) * TP + base + 4 * q4);
#pragma unroll
        for (int j = 0; j < 16; ++j) bv[j] = Tf[(base + j) * TP + base + c];
        float s = 0.f;
#pragma unroll
        for (int j = 0; j < 16; ++j) s += a4[j >> 2][j & 3] * bv[j];
        Lm[(base + i) * TP + base + 16 + c] = s;
    }
    lds_barrier();
    {
        const int base = (tid >> 8) * 32, i = (tid >> 4) & 15, c = tid & 15;
        f32x4 a4[4]; float bv[16];
#pragma unroll
        for (int q4 = 0; q4 < 4; ++q4) a4[q4] = *(const LAS f32x4*)(Tf + (base + 16 + i) * TP + base + 16 + 4 * q4);
#pragma unroll
        for (int j = 0; j < 16; ++j) bv[j] = Lm[(base + j) * TP + base + 16 + c];
        float s = 0.f;
#pragma unroll
        for (int j = 0; j < 16; ++j) s -= a4[j >> 2][j & 3] * bv[j];
        Tf[(base + 16 + i) * TP + base + c] = s; TS[(base + 16 + i) * TP + base + c] = f2bf(s);
    }
    lds_barrier();
    {
        const int c = tid & 31, i0 = tid >> 5;
        float bv[32];
#pragma unroll
        for (int j = 0; j < 32; ++j) bv[j] = Tf[j * TP + c];
#pragma unroll
        for (int rep = 0; rep < 2; ++rep) {
            const int ii = i0 + 16 * rep; f32x4 a4[8];
#pragma unroll
            for (int q4 = 0; q4 < 8; ++q4) a4[q4] = *(const LAS f32x4*)(Lm + (32 + ii) * TP + 4 * q4);
            float s0 = 0.f, s1 = 0.f, s2 = 0.f, s3 = 0.f;
#pragma unroll
            for (int j = 0; j < 32; j += 4) { s0 += a4[j >> 2][0] * bv[j]; s1 += a4[j >> 2][1] * bv[j + 1]; s2 += a4[j >> 2][2] * bv[j + 2]; s3 += a4[j >> 2][3] * bv[j + 3]; }
            Lm[ii * TP + 32 + c] = (s0 + s1) + (s2 + s3);
        }
    }
    lds_barrier();
    {
        const int c = tid & 31, i0 = tid >> 5;
        float bv[32];
#pragma unroll
        for (int j = 0; j < 32; ++j) bv[j] = Lm[j * TP + 32 + c];
#pragma unroll
        for (int rep = 0; rep < 2; ++rep) {
            const int ii = i0 + 16 * rep; f32x4 a4[8];
#pragma unroll
            for (int q4 = 0; q4 < 8; ++q4) a4[q4] = *(const LAS f32x4*)(Tf + (32 + ii) * TP + 32 + 4 * q4);
            float s0 = 0.f, s1 = 0.f, s2 = 0.f, s3 = 0.f;
#pragma unroll
            for (int j = 0; j < 32; j += 4) { s0 += a4[j >> 2][0] * bv[j]; s1 += a4[j >> 2][1] * bv[j + 1]; s2 += a4[j >> 2][2] * bv[j + 2]; s3 += a4[j >> 2][3] * bv[j + 3]; }
            TS[(32 + ii) * TP + c] = f2bf(-((s0 + s1) + (s2 + s3)));
        }
    }
    lds_barrier();
#pragma unroll 1
    for (int repE = 0; repE < (EXP == 14 ? 2 : 1); ++repE) {
        const int mat = w >> 2, rp = (w >> 1) & 1, ch = w & 1;
        bf16x8 a[2][2], bq[4][2];
#pragma unroll
        for (int r2 = 0; r2 < 2; ++r2) ldfr<2>(a[r2], TS + 16 * (2 * rp + r2) * TP, TP, lane);
#pragma unroll
        for (int tt = 0; tt < 4; ++tt) ldfr<2>(bq[tt], (mat ? kbeT : vbT) + 16 * (4 * ch + tt) * TP, TP, lane);
#pragma unroll
        for (int r2 = 0; r2 < 2; ++r2)
#pragma unroll
            for (int tt = 0; tt < 4; ++tt) {
                const int tr = 2 * rp + r2, tc = 4 * ch + tt;
                const f32x4 acc = mmaf<2>(a[r2], bq[tt], (f32x4){0.f, 0.f, 0.f, 0.f});
                u32x2 wv; wv.x = pack2(acc[0], acc[1]); wv.y = pack2(acc[2], acc[3]);
                *(LAS u32x2*)((mat ? kcdT : valT) + (16 * tc + l15) * TP + 16 * tr + quad * 4) = wv;
            }
    }
    lds_barrier();
#pragma unroll 1
    for (int repF = 0; repF < (EXP == 10 ? 2 : 1); ++repF) {
        unsigned char* sA = slot + SLOT_A; unsigned char* sQ = slot + SLOT_Q; unsigned char* sN = slot + SLOT_N; unsigned char* sO = slot + SLOT_O;
        {
            bf16x8 a[2], b1[4][2];
            ldfr<2>(a, kcdT + 16 * w * TP, TP, lane);
#pragma unroll
            for (int tc = 0; tc < 4; ++tc) ldfr<2>(b1[tc], attS + 16 * tc * TP, TP, lane);
            float eg[4]; u32x2 q4[4];
#pragma unroll
            for (int tc = 0; tc < 4; ++tc) { eg[tc] = eS[16 * tc + l15]; q4[tc] = *(const LAS u32x2*)(qS + (16 * tc + l15) * KP + 16 * w + 4 * quad); }
#pragma unroll
            for (int tc = 0; tc < 4; ++tc) {
                const f32x4 a1 = mmaf<2>(a, b1[tc], (f32x4){0.f, 0.f, 0.f, 0.f});
                const f32x4 qf = bf4_to_f32(q4[tc]);
                u32x2 wv; wv.x = pack2(qf[0] * eg[tc] - a1[0], qf[1] * eg[tc] - a1[1]); wv.y = pack2(qf[2] * eg[tc] - a1[2], qf[3] * eg[tc] - a1[3]);
                *(u32x2*)(sQ + (size_t)(unsigned)(((tc * 4 + (w >> 1)) * 64 + ((((w & 1) << 1) | (quad >> 1)) * 16 + l15)) * 16 + (quad & 1) * 8)) = wv;
            }
            const int tr = w & 3, tcb = (w >> 2) * 4;
            bf16x8 a2[2], b2[4][2];
            ldfr<2>(a2, attS + 16 * tr * TP, TP, lane);
#pragma unroll
            for (int tt = 0; tt < 4; ++tt) ldfr<2>(b2[tt], valT + 16 * (tcb + tt) * TP, TP, lane);
#pragma unroll
            for (int tt = 0; tt < 4; ++tt) {
                const f32x4 o = mmaf<2>(a2, b2[tt], (f32x4){0.f, 0.f, 0.f, 0.f});
                u32x2 wv; wv.x = pack2(o[0], o[1]); wv.y = pack2(o[2], o[3]);
                *(u32x2*)(sO + (size_t)(unsigned)((((tr * 8 + tcb + tt) * 64 + lane) * 4) * 2)) = wv;
            }
        }
        {
            const int rq = w >> 1, ch = w & 1;
            bf16x8 ak[2][2], at[2][2], bk[4][2], bv[4][2];
#pragma unroll
            for (int r2 = 0; r2 < 2; ++r2) { ldfr<2>(ak[r2], kcdT + 16 * (2 * rq + r2) * TP, TP, lane); ldfr<2>(at[r2], ktT + 16 * (2 * rq + r2) * TP, TP, lane); }
#pragma unroll
            for (int tt = 0; tt < 4; ++tt) { ldfr<2>(bk[tt], ktT + 16 * (4 * ch + tt) * TP, TP, lane); ldfr<2>(bv[tt], valT + 16 * (4 * ch + tt) * TP, TP, lane); }
#pragma unroll
            for (int r2 = 0; r2 < 2; ++r2)
#pragma unroll
                for (int tt = 0; tt < 4; ++tt) {
                    const int rt = 2 * rq + r2, tc = 4 * ch + tt;
                    const f32x4 a1 = mmaf<2>(ak[r2], bk[tt], (f32x4){0.f, 0.f, 0.f, 0.f}), a2 = mmaf<2>(at[r2], bv[tt], (f32x4){0.f, 0.f, 0.f, 0.f});
                    u32x2 wa; wa.x = pack2(-a1[0], -a1[1]); wa.y = pack2(-a1[2], -a1[3]);
                    *(u32x2*)(sA + (size_t)(unsigned)(((tc * 4 + (rt >> 1)) * 64 + ((((rt & 1) << 1) | (quad >> 1)) * 16 + l15)) * 16 + (quad & 1) * 8)) = wa;
                    u32x2 wv; wv.x = pack2(a2[0], a2[1]); wv.y = pack2(a2[2], a2[3]);
                    *(u32x2*)(sN + (size_t)(unsigned)((((rt * 8 + tc) * 64 + lane) * 4) * 2)) = wv;
                }
        }
        if (tid == 0) *(float*)(slot + SLOT_CD) = __expf(glast);
    }
    lds_barrier();
}

__device__ __forceinline__ void phase_d2(LAS unsigned char* lds, const Params& p, int layer, int c0, int nc, unsigned char* slots, int first_wg, int nwg) {
    const int tid = opaque_tid(), lane = tid & 63, w = __builtin_amdgcn_readfirstlane(tid >> 6);
    const int sh = nc == 16 ? 4 : 0, msk = nc - 1;
    const int nitems = 64 * nc;
    int it = (int)blockIdx.x - first_wg;
    if (it < 0) return;
    D2Pre pre;
    if (it < nitems) { const int seq = it >> sh, st = it & msk; d2_prefetch(pre, p, layer, seq >> 5, (seq >> 2) & 7, seq & 3, c0 + st, w, lane); }
    for (; it < nitems; it += nwg) {
        const int seq = it >> sh, st = it & msk, dir = seq >> 5, b = (seq >> 2) & 7, h = seq & 3;
        const int itn = it + nwg; const bool has_next = itn < nitems; const int nseq = has_next ? itn >> sh : 0, nst = has_next ? itn & msk : 0;
        d2_item(lds, p, layer, dir, b, h, c0 + st, slots + (size_t)it * SLOT, pre, has_next, nseq >> 5, (nseq >> 2) & 7, nseq & 3, c0 + nst);
    }
}

struct D3Regs { bf16x8 a[4], q[4]; u32x2 nt[2], ot; float cd; };
struct D3Off { unsigned a, q, n0, n1, o; };
__device__ __forceinline__ D3Off d3_offsets(int w, int lane, int slice) {
    D3Off f; const int l15 = lane & 15, quad = lane >> 4;
    f.a = SLOT_A + ((w * 4) * 64 + lane) * 16;
    f.q = SLOT_Q + (((w >> 1) * 4) * 64 + lane) * 16;
    f.n0 = SLOT_N + ((w * 8 + slice * 2 + 0) * 64 + lane) * 8;
    f.n1 = SLOT_N + ((w * 8 + slice * 2 + 1) * 64 + lane) * 8;
    f.o = SLOT_O + (((w >> 1) * 8 + slice * 2 + (w & 1)) * 64 + lane) * 8;
    return f;
}
__device__ __forceinline__ D3Regs d3_load(const unsigned char* slot, const D3Off& f) {
    D3Regs r;
#pragma unroll
    for (int ks = 0; ks < 4; ++ks) { r.a[ks] = *(const bf16x8*)(slot + (size_t)(f.a + 1024u * ks)); r.q[ks] = *(const bf16x8*)(slot + (size_t)(f.q + 1024u * ks)); }
    r.nt[0] = *(const u32x2*)(slot + (size_t)f.n0); r.nt[1] = *(const u32x2*)(slot + (size_t)f.n1);
    r.ot = *(const u32x2*)(slot + (size_t)f.o);
    r.cd = *(const float*)(slot + SLOT_CD);
    return r;
}

__device__ __forceinline__ void d3_step(const D3Regs& cur, f32x4 (&S)[2], LAS bf16* ST, int cb, unsigned char* obase, const unsigned (&ooff)[4], int w, int lane) {
    const int quad = lane >> 4, l15 = lane & 15, tco = w & 1;
    const LAS bf16* Sc = ST + cb * 32 * KP;
    bf16x8 bf0[4], bf1[4];
    ldfr<4>(bf0, Sc, KP, lane); ldfr<4>(bf1, Sc + 16 * KP, KP, lane);
    f32x4 a0 = S[0] * cur.cd + bf4_to_f32(cur.nt[0]), a1 = S[1] * cur.cd + bf4_to_f32(cur.nt[1]), ao = bf4_to_f32(cur.ot);
    if (tco) {
#pragma unroll
        for (int ks = 0; ks < 4; ++ks) {
            a0 = __builtin_amdgcn_mfma_f32_16x16x32_bf16(cur.a[ks], bf0[ks], a0, 0, 0, 0);
            a1 = __builtin_amdgcn_mfma_f32_16x16x32_bf16(cur.a[ks], bf1[ks], a1, 0, 0, 0);
            ao = __builtin_amdgcn_mfma_f32_16x16x32_bf16(cur.q[ks], bf1[ks], ao, 0, 0, 0);
        }
    } else {
#pragma unroll
        for (int ks = 0; ks < 4; ++ks) {
            a0 = __builtin_amdgcn_mfma_f32_16x16x32_bf16(cur.a[ks], bf0[ks], a0, 0, 0, 0);
            a1 = __builtin_amdgcn_mfma_f32_16x16x32_bf16(cur.a[ks], bf1[ks], a1, 0, 0, 0);
            ao = __builtin_amdgcn_mfma_f32_16x16x32_bf16(cur.q[ks], bf0[ks], ao, 0, 0, 0);
        }
    }
    S[0] = a0; S[1] = a1;
    LAS bf16* Sw = ST + (cb ^ 1) * 32 * KP;
#pragma unroll
    for (int tc = 0; tc < 2; ++tc) { u32x2 wv; wv.x = pack2(S[tc][0], S[tc][1]); wv.y = pack2(S[tc][2], S[tc][3]); *(LAS u32x2*)(Sw + (16 * tc + l15) * KP + 16 * w + quad * 4) = wv; }
#pragma unroll
    for (int j = 0; j < 4; ++j) *(bf16*)(obase + (size_t)ooff[j]) = f2bf(ao[j]);
    lds_barrier();
}

template <int NC> __device__ __forceinline__ void d3_run(LAS unsigned char* lds, const Params& p, int seg, bool dry) {
    const int tid = opaque_tid(), lane = tid & 63, w = __builtin_amdgcn_readfirstlane(tid >> 6), quad = lane >> 4, l15 = lane & 15;
    LAS bf16* ST = (LAS bf16*)lds;
    const int c0 = seg_start(seg);
    for (int wg = blockIdx.x; wg < 256; wg += gridDim.x) {
        const int xcd = wg & 7, idx = wg >> 3, seq = xcd * 8 + (idx >> 2), slice = idx & 3, dir = seq >> 5, b = (seq >> 2) & 7, h = seq & 3;
        float* sst = (float*)(p.ws + WS_SST) + ((size_t)wg * NT + tid) * 8;
        const unsigned char* slot0 = p.ws + WS_DS + (size_t)(seq * 16) * SLOT;
        const unsigned char* slotx = p.ws + WS_DSX + (size_t)seq * SLOT;
        D3Regs r[3];
        const D3Off off = d3_offsets(w, lane, slice);
        r[0] = d3_load(slot0, off); r[1] = d3_load(slot0 + SLOT, off); r[2] = d3_load(slot0 + 2 * SLOT, off);
        f32x4 S[2];
        if (seg == 0) { S[0] = (f32x4){0.f, 0.f, 0.f, 0.f}; S[1] = S[0]; } else { S[0] = *(const f32x4*)sst; S[1] = *(const f32x4*)(sst + 4); }
        lds_barrier();
#pragma unroll
        for (int tc = 0; tc < 2; ++tc) { u32x2 wv; wv.x = pack2(S[tc][0], S[tc][1]); wv.y = pack2(S[tc][2], S[tc][3]); *(LAS u32x2*)(ST + (16 * tc + l15) * KP + 16 * w + quad * 4) = wv; }
        lds_barrier();
        unsigned char* obuf = p.ws + (dir ? WS_OB : WS_OF);
        unsigned ooff[4];
#pragma unroll
        for (int j = 0; j < 4; ++j) { const int rj = 16 * (w >> 1) + quad * 4 + j; ooff[j] = (unsigned)((dir ? (63 - rj) : rj) * 1024 + (h * 128 + slice * 32 + 16 * (w & 1) + l15) * 2); }
        const unsigned char* sp = slot0 + 3 * SLOT;
        int ncur = c0;
#pragma unroll
        for (int st = 0; st < NC; ++st) {
            unsigned char* ob = obuf + (size_t)row_of(b, 64 * (dir ? 64 - ncur : ncur)) * 1024;
            d3_step(r[st % 3], S, ST, st & 1, ob, ooff, w, lane);
            if (st + 3 < NC) { r[st % 3] = d3_load(st + 3 == 16 ? slotx : sp, off); sp = opaque_ptr(sp + SLOT); }
            asm volatile("" : "+s"(ncur)); ncur += 1;
        }
        if (NC & 1) {
        }
        if (!dry) { *(f32x4*)sst = S[0]; *(f32x4*)(sst + 4) = S[1]; }
    }
}
__device__ __forceinline__ void phase_d3(LAS unsigned char* lds, const Params& p, int seg, bool dry = false) {
    if (seg == 3) d3_run<17>(lds, p, seg, dry); else d3_run<16>(lds, p, seg, dry);
}

__global__ void __launch_bounds__(NT, 2) fwd_kernel(Params p_in) {
    extern __shared__ __attribute__((aligned(16))) unsigned char lds_raw[];
    LAS unsigned char* lds = (LAS unsigned char*)lds_raw;
    cg::grid_group grid = cg::this_grid();
    typedef const __attribute__((address_space(4))) Params* KP;
    const KP kp = (KP)__builtin_amdgcn_kernarg_segment_ptr();
    volatile LAS unsigned* xst = (volatile LAS unsigned*)(lds + LDS_BYTES - 16);
    if (threadIdx.x < 4) xst[threadIdx.x] = 0u;
    __syncthreads();
    if (blockIdx.x == 0) { for (int i = threadIdx.x; i < XCD_BAR_WORDS; i += NT) ((unsigned*)(p_in.ws + WS_BAR))[i] = 0u; __threadfence(); }
    grid.sync();
    XcdBarrier xbar = xcd_barrier_post((unsigned*)(p_in.ws + WS_BAR), xst);
    const int G = gridDim.x, bx = blockIdx.x;
    const int ph_lo = p_in.ph_lo, ph_hi = p_in.ph_hi;
    for (int ph0 = ph_lo; ph0 < ph_hi; ++ph0) {
        int ph = ph0; asm volatile("" : "+s"(ph));
        const Params& p = p_in;
        unsigned char* ws = p.ws;
#ifndef EXP
#define EXP 0
#endif
        if (ph == 0) { phase_prologue(lds, p); if (EXP == 2) { __syncthreads(); phase_prologue(lds, p); } }
        else {
            const int layer = (ph - 1) / 18, sub0r = (ph - 1) % 18, sub0 = sub0r <= 12 ? sub0r : sub0r + 1;
            const int sub = sub0 <= 3 ? sub0 : (sub0 <= 10 ? sub0 + 1 : (sub0 == 11 ? 14 : sub0 + 4));
            bool is_gemm = false; int ncall = 1; int tailsplit = 0;
            int d2_c0 = -1, d2_nc = 16, d2_first = 0, d2_nwg = G; unsigned char* d2_slots = ws + WS_DS;
            pg8::Gemm g{nullptr, nullptr, 0, 0, 0}; pg8::Epi E{}; int swz = 1;
            bf16* XB = (bf16*)(ws + WS_XB);
            const int MR = (layer == 1) ? NMAIN : NROWS;
            if (sub == 0) { is_gemm = true; g = pg8::Gemm{XB, (bf16*)(ws + WS_WIN) + (size_t)layer * NIN * 1024, NROWS, N1, 1024, 1024};
                E.mode = pg8::EP_PROJ1; E.uf = (bf16*)(ws + WS_UF); E.qkv = (bf16*)(ws + WS_QKV); E.z = (bf16*)(ws + WS_Z); E.bd = (float*)(ws + WS_BD); }
            else if (sub == 1) { phase_fold(lds, p); if (EXP == 5) { __syncthreads(); phase_fold(lds, p); } }
            else if (sub == 2) { is_gemm = true; ncall = 4; swz = 0; }
            else if (sub == 3) { phase_unfold(lds, p); if (EXP == 5) phase_unfold(lds, p); d2_c0 = 0; }
            else if (sub < 12) { const int s = (sub - 4) >> 1; if ((sub - 4) & 1) { if (EXP == 4) { phase_d3(lds, p, s, true); __syncthreads(); } phase_d3(lds, p, s); } else { d2_c0 = 16 * s; } }
            else if (sub == 14) { is_gemm = true; g = pg8::Gemm{XB, (bf16*)(ws + WS_WIN) + (size_t)layer * NIN * 1024 + (size_t)N1 * 1024, MR, N2, 1024, 1024};
                E.mode = pg8::EP_SIGM; E.o = (bf16*)(ws + WS_G); E.ldc = 2048; }

            else if (sub == 16) { is_gemm = true; g = pg8::Gemm{(bf16*)(ws + WS_UF), (bf16*)(ws + WS_WFP) + (size_t)layer * 1024 * 512, MR, 1024, 512, 512};
                E.mode = pg8::EP_MERGE0; E.o = (bf16*)(ws + WS_TMP); E.ldc = 1024; E.gate = (bf16*)(ws + WS_G); ncall = 2; }
            else if (sub == 17) { is_gemm = true; g = pg8::Gemm{(bf16*)(ws + WS_OF), (bf16*)(ws + WS_WDP) + (size_t)layer * 1024 * 512, MR, 1024, 512, 512};
                E.mode = pg8::EP_MERGE1; E.o = (bf16*)(ws + WS_TMP); E.ldc = 1024; E.gate = (bf16*)(ws + WS_G) + 1024; }
            else if (sub == 18) { is_gemm = true; g = pg8::Gemm{(bf16*)(ws + WS_TMP), (bf16*)(ws + WS_WOUT) + (size_t)layer * 1024 * 1024, MR, 1024, 1024, 1024};
                E.mode = pg8::EP_RES; E.o = XB; E.ldc = 1024; g.M = NMAIN; if (layer == 0) { ncall = 2; tailsplit = 256; } }
            else if (sub == 19) phase_ln(p, p.ln1g + layer * 1024, p.ln1b + layer * 1024, false, layer == 0 ? (const float*)(ws + WS_TOUT) : nullptr, 4, MR);
            else if (sub == 20) { is_gemm = true; g = pg8::Gemm{XB, (bf16*)(ws + WS_WUP) + (size_t)layer * 4096 * 1024, MR, DFF, 1024, 1024};
                E.mode = pg8::EP_SQRELU; E.o = (bf16*)(ws + WS_H); E.ldc = DFF; }
            else if (sub == 21) { is_gemm = true; g = pg8::Gemm{(bf16*)(ws + WS_H), (bf16*)(ws + WS_WDN) + (size_t)layer * 1024 * 4096, MR, 1024, DFF, DFF};
                E.mode = pg8::EP_RES; E.o = XB; E.ldc = 1024; g.M = NMAIN; if (layer == 0) { ncall = 2; tailsplit = 512; } }
            else phase_ln(p, p.ln2g + layer * 1024, p.ln2b + layer * 1024, layer == 1, layer == 0 ? (const float*)(ws + WS_TDN) : nullptr, 8, MR);
            if (is_gemm) {
                for (int call = 0; call < ncall; ++call) {
                    int c = bx;
                    if (sub == 2) {
                        const int par = call & 1, off = call == 0 ? 0 : (call == 1 ? 45 : (call == 2 ? 90 : 130));
                        if (call < 2) g = pg8::Gemm{(bf16*)(ws + WS_CM) + (size_t)par * DFT_M * DFT_K, (bf16*)(ws + WS_ECT) + (size_t)par * DFT_NC * DFT_K, DFT_M, DFT_NC, DFT_K, DFT_K};
                        else g = pg8::Gemm{(bf16*)(ws + WS_SM) + (size_t)par * DFT_M * DFT_K, (bf16*)(ws + WS_EST) + (size_t)par * DFT_NS * DFT_K, DFT_M, DFT_NS, DFT_K, DFT_K};
                        E.mode = pg8::EP_F32; E.ldc = g.N;
                        E.of32 = (float*)(ws + (call < 2 ? WS_P : WS_Q)) + (size_t)par * DFT_M * g.N;
                        c = (bx + G - (off % G)) % G;
                    }
                    if (sub == 16 && call == 1) { g.A = (bf16*)(ws + WS_OF); g.Bt = (bf16*)(ws + WS_WDP) + (size_t)layer * 1024 * 512; E.mode = pg8::EP_MERGE1; E.gate = (bf16*)(ws + WS_G) + 1024; }
                    pg8::Order S; S.init(g.M, g.N, G, c, swz);
                    if (tailsplit && call == 1) {
                        g.K = tailsplit; E.mode = pg8::EP_PART; E.of32 = (float*)(ws + (sub == 18 ? WS_TOUT : WS_TDN)); E.goff = NMAIN;
                        S.init_split(2, NMAIN / 256, 1024, g.ld / tailsplit, tailsplit * 2, G, c);
                    }
                    __syncthreads();
                    pg8::gemm_phase<pg8::Epi, pg8::Order, true, true>(lds, g, S, E);
                    __syncthreads();
                    if (sub == 2 && call == 3) { d2_c0 = 64; d2_nc = 1; d2_slots = ws + WS_DSX; if (G >= 234) { d2_first = 170; d2_nwg = G - 170; } }
                    if (sub == 14) {
                        const int nun = (g.M / 256) * (g.N / 256), tailw = nun % G;
                        __syncthreads();
                        const int cf = (tailw > 0 && tailw < G / 2) ? tailw : 0; phase_combine(p, layer, cf, G - cf, MR);
                    }
                    if (EXP == 6 && sub == 20 && call == 0) { ncall = 2; }
                    if (EXP == 7 && sub == 0 && call == 0) { ncall = 2; }
                }
            }
            if (d2_c0 >= 0) { __syncthreads(); phase_d2(lds, p, layer, d2_c0, d2_nc, d2_slots, d2_first, d2_nwg); }
        }
        if (ph0 + 1 < ph_hi) { xcd_barrier(xbar); if (EXP == 1) xcd_barrier(xbar); }
    }
}

#ifndef N_LAUNCH_MODE
#define N_LAUNCH_MODE 1
#endif
extern "C" void kernel_launch(void* const* d_in, const int* in_sizes, int n_in, void* d_out, int out_size, void* d_ws, size_t ws_size, hipStream_t stream) {
    static int grid = 0;
    if (grid == 0) {
        if (n_in != 18 || ws_size < WS_END) { fprintf(stderr, "kernel_launch: unexpected n_in %d / ws_size %zu (need %zu)\n", n_in, ws_size, (size_t)WS_END); grid = -1; return; }
        int dev = 0, cus = 0, per_cu = 0;
        hipGetDevice(&dev); hipDeviceGetAttribute(&cus, hipDeviceAttributeMultiprocessorCount, dev);
        if (hipFuncSetAttribute((const void*)fwd_kernel, hipFuncAttributeMaxDynamicSharedMemorySize, LDS_BYTES) != hipSuccess) { fprintf(stderr, "kernel_launch: hipFuncSetAttribute failed\n"); grid = -1; return; }
        hipOccupancyMaxActiveBlocksPerMultiprocessor(&per_cu, (const void*)fwd_kernel, NT, LDS_BYTES);
        if (per_cu < 1) { fprintf(stderr, "kernel_launch: occupancy query says %d blocks per CU\n", per_cu); per_cu = 1; }
        (void)hipGetLastError();
        grid = cus * 1;
        fprintf(stderr, "kernel_launch: grid %d (cus %d, per_cu %d)\n", grid, cus, per_cu);
    }
    if (grid < 0) return;
    Params p{};
    const float** pf = (const float**)&p;
    for (int i = 0; i < 18; ++i) pf[i] = (const float*)d_in[i];
    p.out = (float*)d_out; p.ws = (unsigned char*)d_ws;
    const int NPH = 37;
    if (N_LAUNCH_MODE == 1) {
        p.ph_lo = 0; p.ph_hi = NPH;
        void* args[] = {&p};
        hipError_t e = hipLaunchCooperativeKernel((const void*)fwd_kernel, dim3(grid), dim3(NT), args, LDS_BYTES, stream);
        if (e != hipSuccess) fprintf(stderr, "cooperative launch failed: %s (grid %d)\n", hipGetErrorString(e), grid);
    } else {
        for (int ph = 0; ph < NPH; ++ph) {
            p.ph_lo = ph; p.ph_hi = ph + 1;
            void* args[] = {&p};
            hipError_t e = hipLaunchCooperativeKernel((const void*)fwd_kernel, dim3(grid), dim3(NT), args, LDS_BYTES, stream);
            if (e != hipSuccess) { fprintf(stderr, "launch %d failed: %s\n", ph, hipGetErrorString(e)); break; }
        }
    }
}
```

```cpp
#include <hip/hip_runtime.h>
#include <hip/hip_cooperative_groups.h>
#include <cstdio>
#include <cstdint>
namespace cg = cooperative_groups;

#define LAS __attribute__((address_space(3)))
typedef unsigned short bf16;
typedef short bf16x8 __attribute__((ext_vector_type(8)));
typedef float f32x4 __attribute__((ext_vector_type(4)));
typedef unsigned u32x4 __attribute__((ext_vector_type(4)));
typedef unsigned u32x2 __attribute__((ext_vector_type(2)));

constexpr int DM = 1024, NBATCH = 8, SEQ = 4096, NMETA = 16, LTOK = 4112, LPAD = 4160, NROWS = NBATCH * LPAD  , PADR = 48;
constexpr int HALF_L = 2056;
constexpr int NMAIN = NBATCH * SEQ;
__device__ __forceinline__ int row_of(int b, int pp) { return pp >= 64 ? b * SEQ + (pp - 64) : NMAIN + b * 64 + pp; }
__device__ __forceinline__ void pos_of(int r, int& b, int& pp) { if (r < NMAIN) { b = r >> 12; pp = 64 + (r & 4095); } else { const int q = r - NMAIN; b = q >> 6; pp = q & 63; } }
constexpr int DFT_M = 1280, DFT_K = 1152, DFT_NC = 2304, DFT_NS = 2048;
constexpr int N1 = 2816, N2 = 2048, NIN = 4864, DFF = 4096, INW = 4624;
constexpr int NSEG = 4;
constexpr int SLOT_A = 0, SLOT_Q = 32768, SLOT_N = 49152, SLOT_O = 81920, SLOT_CD = 98304, SLOT = 98560;
constexpr float ALPHA = 1.41421356237f;

constexpr size_t MiB = 1048576;
constexpr size_t WS_WIN = 0, WS_WUP = 19 * MiB, WS_WDN = 35 * MiB, WS_WOUT = 51 * MiB, WS_WFP = 55 * MiB, WS_WDP = 57 * MiB, WS_CM = 59 * MiB, WS_SM = 69 * MiB;
constexpr size_t WS_XB = 80 * MiB, WS_H = 145 * MiB, WS_UF = 145 * MiB, WS_QKV = 178 * MiB, WS_TMP = 178 * MiB, WS_Z = 276 * MiB, WS_OF = 309 * MiB, WS_OB = 342 * MiB;
constexpr size_t WS_BD = 375 * MiB, WS_ECT = 309 * MiB, WS_EST = 320 * MiB, WS_P = 329 * MiB, WS_Q = 352 * MiB,     WS_DS = 378 * MiB, WS_G = 378 * MiB, WS_SST = 482 * MiB, WS_DSX = 475 * MiB, WS_TOUT = 300 * MiB, WS_TDN = 410 * MiB;
constexpr size_t WS_BAR = 508 * MiB;
constexpr size_t WS_END = 509 * MiB;
constexpr int LDS_BYTES = 147456;

struct Params {
    const float *x, *meta, *ln0g, *ln0b, *w_in, *conv_w, *a_log, *dt_bias, *dng, *w_fp, *w_dp, *w_out, *ln1g, *ln1b, *w_up, *w_down, *ln2g, *ln2b;
    float* out; unsigned char* ws; int ph_lo, ph_hi;
};

__device__ __forceinline__ int opaque_tid() { int t = threadIdx.x; asm volatile("" : "+v"(t)); return t; }
template <class T> __device__ __forceinline__ T* opaque_ptr(T* q) { asm volatile("" : "+s"(q)); return q; }
__device__ __forceinline__ void lds_barrier() { asm volatile("s_waitcnt lgkmcnt(0)" ::: "memory"); __builtin_amdgcn_s_barrier(); asm volatile("" ::: "memory"); }
__device__ __forceinline__ float bf2f(unsigned short h) { return __uint_as_float(((unsigned)h) << 16); }
typedef float f32x2c __attribute__((ext_vector_type(2)));
typedef __bf16 bf16x2c __attribute__((ext_vector_type(2)));
__device__ __forceinline__ unsigned pack2(float lo, float hi) { const f32x2c v = {lo, hi}; const bf16x2c r = __builtin_convertvector(v, bf16x2c); return __builtin_bit_cast(unsigned, r); }
__device__ __forceinline__ unsigned short f2bf(float f) { return (unsigned short)(pack2(f, 0.f) & 0xffffu); }
__device__ __forceinline__ float wave_sum(float v) {
#pragma unroll
    for (int o = 32; o; o >>= 1) v += __shfl_xor(v, o);
    return v;
}
__device__ __forceinline__ float sigmoidf_(float x) { return __builtin_amdgcn_rcpf(1.0f + __expf(-x)); }
#define XB_TMO      128
#define XB_XCNT(j)  (256  + 64 * (j))
#define XB_XSUB(j)  (1280 + 64 * (j))
#define XB_XGEN(j)  (2304 + 64 * (j))
#define XB_TOP      3328
#define XB_TOPGEN   3392
#define XCD_BAR_WORDS 3456
#define XB_SPIN_CAP (1u << 18)

__device__ __forceinline__ unsigned xb_ld(unsigned* p)              { return __hip_atomic_load(p, __ATOMIC_RELAXED, __HIP_MEMORY_SCOPE_AGENT); }
__device__ __forceinline__ unsigned xb_add(unsigned* p, unsigned v) { return __hip_atomic_fetch_add(p, v, __ATOMIC_RELAXED, __HIP_MEMORY_SCOPE_AGENT); }
__device__ __forceinline__ unsigned xb_xcc_id() { return (unsigned)__builtin_amdgcn_s_getreg((3 << 11) | 20) & 0xFu; }
#define XB_SPIN(cond, bar) do { unsigned _sp = 0; while (cond) { __builtin_amdgcn_s_sleep(1); \
    if ((++_sp & 255u) == 0u) { if (xb_ld(&(bar)[XB_TMO])) break; if (_sp > XB_SPIN_CAP) { atomicAdd(&(bar)[XB_TMO], 1u); break; } } } } while (0)

struct XcdBarrier {
    unsigned* bar; unsigned x;
    volatile LAS unsigned* st;
};

__device__ __forceinline__ XcdBarrier xcd_barrier_post(unsigned* bar, volatile LAS unsigned* st) {
    XcdBarrier b; b.bar = bar; b.x = xb_xcc_id(); b.st = st;
    if (threadIdx.x == 0) (void)xb_add(&bar[XB_XCNT(b.x)], 1u);
    return b;
}
__device__ __forceinline__ void xcd_barrier_complete(unsigned* bar, unsigned x, unsigned& nloc, unsigned& nx) {
    const unsigned G = gridDim.x * gridDim.y * gridDim.z;
    unsigned sum, cnt, mine, sp = 0u;
    for (;;) {
        sum = 0u; cnt = 0u; mine = 0u;
#pragma unroll
        for (unsigned j = 0; j < 16; ++j) { const unsigned c = xb_ld(&bar[XB_XCNT(j)]); sum += c; cnt += (c > 0u) ? 1u : 0u; mine = (j == x) ? c : mine; }
        if (sum == G) break;
        __builtin_amdgcn_s_sleep(1);
        if ((++sp & 255u) == 0u) { if (xb_ld(&bar[XB_TMO])) break; if (sp > XB_SPIN_CAP) { atomicAdd(&bar[XB_TMO], 1u); break; } }
    }
    nloc = mine > 0u ? mine : 1u; nx = cnt > 0u ? cnt : 1u;
}

__device__ __forceinline__ void xcd_barrier(const XcdBarrier& b) {
    asm volatile("s_waitcnt vmcnt(0)" ::: "memory");
    __syncthreads();
    if (threadIdx.x == 0) {
        unsigned* bar = b.bar;
        __builtin_amdgcn_s_waitcnt(0);
        unsigned nloc = b.st[0], nx = b.st[1];
        if (nloc == 0u) { xcd_barrier_complete(bar, b.x, nloc, nx); b.st[0] = nloc; b.st[1] = nx; }
        const unsigned old = xb_add(&bar[XB_XSUB(b.x)], 1u);
        const unsigned gen = old / nloc;
        if (old + 1u == (gen + 1u) * nloc) {
            __builtin_amdgcn_fence(__ATOMIC_RELEASE, "agent");
            asm volatile("s_waitcnt vmcnt(0)" ::: "memory");
            const unsigned og = xb_add(&bar[XB_TOP], 1u);
            const unsigned tg = og / nx;
            if (og + 1u == (tg + 1u) * nx) xb_add(&bar[XB_TOPGEN], 1u);
            else XB_SPIN(xb_ld(&bar[XB_TOPGEN]) == tg, bar);
            __builtin_amdgcn_fence(__ATOMIC_ACQUIRE, "agent");
            xb_add(&bar[XB_XGEN(b.x)], 1u);
            asm volatile("s_waitcnt vmcnt(0)" ::: "memory");
        } else {
            XB_SPIN(xb_ld(&bar[XB_XGEN(b.x)]) == gen, bar);
            __builtin_amdgcn_fence(__ATOMIC_ACQUIRE, "agent");
            asm volatile("s_waitcnt vmcnt(0)" ::: "memory");
        }
    }
    __syncthreads();
}

namespace pg8 {
#define PG8_LAS __attribute__((address_space(3)))
typedef unsigned short bf16_t;
typedef short bf16x8 __attribute__((ext_vector_type(8)));
typedef float f32x4 __attribute__((ext_vector_type(4)));
typedef unsigned u32x4 __attribute__((ext_vector_type(4)));
constexpr int BM = 256, BK = 64, HALF = 128, HTB = HALF * BK * 2  , STAGE_BYTES = 8 * HTB, NXCD = 8, WGM = 8;

__host__ __device__ __forceinline__ int lds_byte(int r, int c) { const int st = (r >> 4) * 2 + (c >> 5), rr = r & 15, cc = c & 31, ob = rr * 64 + cc * 2; return st * 1024 + (ob ^ (((ob >> 9) & 1) << 5)); }
__host__ __device__ __forceinline__ void stage_rc(int b, int& R, int& C) { const int st = b / 1024, sb = b % 1024, swz = sb ^ (((sb >> 9) & 1) << 5); R = (st >> 1) * 16 + swz / 64; C = (st & 1) * 32 + (swz % 64) / 2; }
__host__ __device__ __forceinline__ int perm32(int rho) { const int n = rho >> 4, i = rho & 15; return 8 * (i >> 2) + 4 * n + (i & 3); }

struct Unit { int pm, pn, koff, kp; };
struct Gemm { const bf16_t* A; const bf16_t* Bt; int M, N, K, ld; };

struct StaticOrder {
    int nM, nN, nwg, G, c;
    __host__ __device__ void init(int M, int N, int G_, int c_) { nM = M / BM; nN = N / BM; nwg = nM * nN; G = G_; c = c_; }
    __host__ __device__ bool next(int i, Unit& u) const {
        const long L = (long)i * G + c; if (L >= nwg) return false;
        int wgid = (int)L; { const int q = nwg / NXCD, r = nwg % NXCD, xcd = wgid % NXCD, off = wgid / NXCD; wgid = (xcd < r ? xcd * (q + 1) : r * (q + 1) + (xcd - r) * q) + off; }
        const int nig = WGM * nN, gid = wgid / nig, fm = gid * WGM, gsz = (nM - fm) < WGM ? (nM - fm) : WGM;
        u.pm = fm + ((wgid % nig) % gsz); u.pn = (wgid % nig) / gsz; u.koff = 0; u.kp = 0; return true;
    }
    __device__ __forceinline__ void a_ready(const Unit&) const {}
    __device__ __forceinline__ void done(const Unit&) const {}
};
__device__ __forceinline__ unsigned cvt_pk_bf16(float lo, float hi) { return ::pack2(lo, hi); }
__device__ __forceinline__ u32x4 pack8(f32x4 v0, f32x4 v1) { u32x4 w; w.x = cvt_pk_bf16(v0[0], v0[1]); w.y = cvt_pk_bf16(v0[2], v0[3]); w.z = cvt_pk_bf16(v1[0], v1[1]); w.w = cvt_pk_bf16(v1[2], v1[3]); return w; }
__device__ __forceinline__ void unpack8(u32x4 w, f32x4& v0, f32x4& v1) {
    v0[0] = __uint_as_float(w.x << 16); v0[1] = __uint_as_float(w.x & 0xffff0000u); v0[2] = __uint_as_float(w.y << 16); v0[3] = __uint_as_float(w.y & 0xffff0000u);
    v1[0] = __uint_as_float(w.z << 16); v1[1] = __uint_as_float(w.z & 0xffff0000u); v1[2] = __uint_as_float(w.w << 16); v1[3] = __uint_as_float(w.w & 0xffff0000u);
}
__device__ __forceinline__ float sigm(float x) { return __builtin_amdgcn_rcpf(1.0f + __expf(-x)); }
enum { EP_PROJ1 = 0, EP_SIGM = 1, EP_F32 = 2, EP_MERGE0 = 3, EP_MERGE1 = 4, EP_RES = 5, EP_SQRELU = 6, EP_PART = 7 };
struct Epi {
    static constexpr bool PERM = true, AFTER_DRAIN = false;
    int mode; int ldc; int goff; bf16_t* o; float* of32; const bf16_t* gate; bf16_t* uf; bf16_t* qkv; bf16_t* z; float* bd;
    __device__ __forceinline__ void operator()(const f32x4 (&acc)[2][2][4][2], const Unit& u, int wr, int wc, int fr, int fq) const {
        const int row0 = u.pm * BM + wr * 64 + fr, cl = wc * 32 + 8 * fq;
        if (mode == EP_RES) {
#pragma unroll
            for (int ai = 0; ai < 2; ++ai) {
                u32x4 l0[4][2];
#pragma unroll
                for (int m = 0; m < 4; ++m)
#pragma unroll
                    for (int bj = 0; bj < 2; ++bj) l0[m][bj] = *(const u32x4*)(o + (size_t)(row0 + ai * HALF + m * 16) * ldc + u.pn * BM + bj * HALF + cl);
#pragma unroll
                for (int m = 0; m < 4; ++m)
#pragma unroll
                    for (int bj = 0; bj < 2; ++bj) {
                        f32x4 v0 = acc[ai][bj][m][0], v1 = acc[ai][bj][m][1], p0, p1; unpack8(l0[m][bj], p0, p1);
                        v0 = v0 + p0 * 1.41421356237f; v1 = v1 + p1 * 1.41421356237f;
                        *(u32x4*)(o + (size_t)(row0 + ai * HALF + m * 16) * ldc + u.pn * BM + bj * HALF + cl) = pack8(v0, v1);
                    }
            }
            return;
        }
        if (mode == EP_MERGE0) {
#pragma unroll
            for (int ai = 0; ai < 2; ++ai) {
                u32x4 l0[4][2];
#pragma unroll
                for (int m = 0; m < 4; ++m)
#pragma unroll
                    for (int bj = 0; bj < 2; ++bj) l0[m][bj] = *(const u32x4*)(gate + (size_t)(row0 + ai * HALF + m * 16) * 2048 + u.pn * BM + bj * HALF + cl);
#pragma unroll
                for (int m = 0; m < 4; ++m)
#pragma unroll
                    for (int bj = 0; bj < 2; ++bj) {
                        f32x4 v0 = acc[ai][bj][m][0], v1 = acc[ai][bj][m][1], p0, p1; unpack8(l0[m][bj], p0, p1);
                        *(u32x4*)(o + (size_t)(row0 + ai * HALF + m * 16) * ldc + u.pn * BM + bj * HALF + cl) = pack8(v0 * p0, v1 * p1);
                    }
            }
            return;
        }
        if (mode == EP_MERGE1) {
#pragma unroll
            for (int ai = 0; ai < 2; ++ai)
#pragma unroll
                for (int mh = 0; mh < 2; ++mh) {
                    u32x4 l0[2][2], l1[2][2];
#pragma unroll
                    for (int m2 = 0; m2 < 2; ++m2)
#pragma unroll
                        for (int bj = 0; bj < 2; ++bj) {
                            const size_t row = (size_t)(row0 + ai * HALF + (mh * 2 + m2) * 16); const int col = u.pn * BM + bj * HALF + cl;
                            l0[m2][bj] = *(const u32x4*)(gate + row * 2048 + col);
                            l1[m2][bj] = (u32x4){0u, 0u, 0u, 0u};
                            if (mode == EP_MERGE1) l1[m2][bj] = *(const u32x4*)(o + row * ldc + col);
                        }
#pragma unroll
                    for (int m2 = 0; m2 < 2; ++m2)
#pragma unroll
                        for (int bj = 0; bj < 2; ++bj) {
                            const int m = mh * 2 + m2;
                            const size_t row = (size_t)(row0 + ai * HALF + m * 16); const int col = u.pn * BM + bj * HALF + cl;
                            f32x4 v0 = acc[ai][bj][m][0], v1 = acc[ai][bj][m][1], p0, p1, q0, q1; unpack8(l0[m2][bj], p0, p1); unpack8(l1[m2][bj], q0, q1);
                            v0 = v0 * p0 + q0; v1 = v1 * p1 + q1;
                            *(u32x4*)(o + row * ldc + col) = pack8(v0, v1);
                        }
                }
            return;
        }
#pragma unroll
        for (int ai = 0; ai < 2; ++ai)
#pragma unroll
            for (int m = 0; m < 4; ++m) {
                const size_t row = (size_t)(row0 + ai * HALF + m * 16);
#pragma unroll
                for (int bj = 0; bj < 2; ++bj) {
                    const int col = u.pn * BM + bj * HALF + cl;
                    f32x4 v0 = acc[ai][bj][m][0], v1 = acc[ai][bj][m][1];
                    if (mode == EP_PROJ1) {
                        if (u.pn < 2) { *(u32x4*)(uf + row * 512 + col) = pack8(v0, v1); }
                        else if (u.pn < 8) { *(u32x4*)(qkv + row * 1536 + (col - 512)) = pack8(v0, v1); }
                        else if (u.pn < 10) {
#pragma unroll
                            for (int e = 0; e < 4; ++e) { v0[e] = v0[e] * sigm(v0[e]); v1[e] = v1[e] * sigm(v1[e]); }
                            *(u32x4*)(z + row * 512 + (col - 2048)) = pack8(v0, v1);
                        } else { if (bj == 0 && wc == 0 && fq < 2) { float* d = bd + row * 16 + 8 * fq; *(f32x4*)d = v0; *(f32x4*)(d + 4) = v1; } }
                    } else if (mode == EP_SIGM) {
#pragma unroll
                        for (int e = 0; e < 4; ++e) { v0[e] = sigm(v0[e]); v1[e] = sigm(v1[e]); }
                        *(u32x4*)(o + row * ldc + col) = pack8(v0, v1);
                    } else if (mode == EP_F32) {
                        float* d = of32 + row * ldc + col; *(f32x4*)d = v0; *(f32x4*)(d + 4) = v1;
                    } else if (mode == EP_PART) {
                        float* d = of32 + ((size_t)u.kp * 512 + (row - (size_t)goff)) * 1024 + col; *(f32x4*)d = v0; *(f32x4*)(d + 4) = v1;
                    } else {
#pragma unroll
                        for (int e = 0; e < 4; ++e) { float a = v0[e] > 0.f ? v0[e] : 0.f, b = v1[e] > 0.f ? v1[e] : 0.f; v0[e] = a * a; v1[e] = b * b; }
                        *(u32x4*)(o + row * ldc + col) = pack8(v0, v1);
                    }
                }
            }
    }
};
struct Order {
    int nM, nN, nwg, G, c, swz, ks, kbytes, pm0;
    __device__ void init(int M, int N, int G_, int c_, int swz_) { nM = M / BM; nN = N / BM; nwg = nM * nN; G = G_; c = c_; swz = swz_; ks = 1; kbytes = 0; pm0 = 0; }
    __device__ void init_split(int ntile, int pm0_, int N, int ks_, int kbytes_, int G_, int c_) { nM = ntile; nN = N / BM; ks = ks_; kbytes = kbytes_; pm0 = pm0_; nwg = nM * nN * ks; G = G_; c = c_; swz = 2; }
    __device__ bool next(int i, Unit& u) const {
        const long L = (long)i * G + c; if (L >= nwg) return false;
        u.koff = 0; u.kp = 0;
        if (swz == 2) { const int l = (int)L; u.kp = l % ks; u.koff = u.kp * kbytes; const int r = l / ks; u.pn = r % nN; u.pm = pm0 + r / nN; return true; }
        if (!swz) { u.pm = (int)L % nM; u.pn = (int)L / nM; return true; }
        int wgid = (int)L; { const int q = nwg / NXCD, r = nwg % NXCD, xcd = wgid % NXCD, off = wgid / NXCD; wgid = (xcd < r ? xcd * (q + 1) : r * (q + 1) + (xcd - r) * q) + off; }
        const int nig = WGM * nN, gid = wgid / nig, fm = gid * WGM, gsz = (nM - fm) < WGM ? (nM - fm) : WGM;
        u.pm = fm + ((wgid % nig) % gsz); u.pn = (wgid % nig) / gsz; return true;
    }
    __device__ __forceinline__ void a_ready(const Unit&) const {}
    __device__ __forceinline__ void done(const Unit&) const {}
};
template <class Epi, class Sched, bool ALIGN_EPI = false, bool SP2 = false>
__device__ __forceinline__ void gemm_phase(PG8_LAS unsigned char* lds, const Gemm g, const Sched& S, const Epi& E) {
    const int tid = opaque_tid(), wid = __builtin_amdgcn_readfirstlane(tid >> 6), lane = tid & 63, wr = wid >> 2, wc = wid & 3, fr = lane & 15, fq = lane >> 4;
    const int K = g.K, nt = K / BK, LD = g.ld;
    unsigned voffA[2], voffB[2];
#pragma unroll
    for (int i = 0; i < 2; ++i) { int R, C; stage_rc(tid * 16 + i * 8192, R, C); const int Rb = Epi::PERM ? ((R & ~31) + perm32(R & 31)) : R;
        voffA[i] = (unsigned)(R * LD + C) * 2u; voffB[i] = (unsigned)(Rb * LD + C) * 2u; }
    const size_t kstep = (size_t)(BK * 2);
    const size_t hstep = (size_t)HALF * LD * 2;
    const size_t tstep = 2 * hstep;
    const unsigned ldsw = (unsigned)wid * 1024u;
    const int aoff = lds_byte(wr * 64 + fr, fq * 8), boff = lds_byte(wc * 32 + fr, fq * 8);
#define PG8_SA(b, h) (((b) * 2 + (h)) * HTB)
#define PG8_SB(b, h) ((4 + (b) * 2 + (h)) * HTB)
#define PG8_STAGE(bufoff, gbase, voff) do { _Pragma("unroll") for (int _i = 0; _i < 2; ++_i) \
        __builtin_amdgcn_global_load_lds((const unsigned*)((const char*)(gbase) + (voff)[_i]), (PG8_LAS unsigned*)(lds + (bufoff) + ldsw + _i * 8192), 16, 0, 0); } while (0)
#define PG8_LDA(dst, b, h) do { _Pragma("unroll") for (int m = 0; m < 4; ++m) _Pragma("unroll") for (int k = 0; k < 2; ++k) dst[m][k] = *(const PG8_LAS bf16x8*)(lds + PG8_SA(b, h) + aoff + m * 2048 + k * 1024); } while (0)
#define PG8_LDB(dst, b, h) do { _Pragma("unroll") for (int n = 0; n < 2; ++n) _Pragma("unroll") for (int k = 0; k < 2; ++k) dst[n][k] = *(const PG8_LAS bf16x8*)(lds + PG8_SB(b, h) + boff + n * 2048 + k * 1024); } while (0)
#define PG8_MMA(ai, bj, At, Bt) do { __builtin_amdgcn_s_setprio(1); _Pragma("unroll") for (int m = 0; m < 4; ++m) _Pragma("unroll") for (int n = 0; n < 2; ++n) _Pragma("unroll") for (int k = 0; k < 2; ++k) \
        acc[ai][bj][m][n] = __builtin_amdgcn_mfma_f32_16x16x32_bf16(Bt[n][k], At[m][k], acc[ai][bj][m][n], 0, 0, 0); __builtin_amdgcn_s_setprio(0); } while (0)
#define PG8_WAIT_V(n) asm volatile("s_waitcnt vmcnt(" #n ")" ::: "memory")
#define PG8_WAIT_L(n) asm volatile("s_waitcnt lgkmcnt(" #n ")" ::: "memory")
#define PG8_BAR __builtin_amdgcn_s_barrier()
#define PG8_SCHED __builtin_amdgcn_sched_barrier(0)
    Unit cur, nxt; int ui = 0;
    if (!S.next(0, cur)) return;
    f32x4 acc[2][2][4][2];
#pragma unroll
    for (int a = 0; a < 2; ++a)
#pragma unroll
        for (int b = 0; b < 2; ++b)
#pragma unroll
            for (int m = 0; m < 4; ++m)
#pragma unroll
                for (int n = 0; n < 2; ++n) acc[a][b][m][n] = (f32x4){0.f, 0.f, 0.f, 0.f};
    bf16x8 At[4][2], B0[2][2], B1[2][2];
    const char* cA = (const char*)g.A + (size_t)cur.pm * tstep + cur.koff; const char* cB = (const char*)g.Bt + (size_t)cur.pn * tstep + cur.koff;
    S.a_ready(cur);
    if constexpr (SP2) {
        PG8_STAGE(PG8_SB(0, 0), cB, voffB); PG8_STAGE(PG8_SB(0, 1), cB + hstep, voffB); PG8_STAGE(PG8_SA(0, 0), cA, voffA); PG8_STAGE(PG8_SA(0, 1), cA + hstep, voffA);
        if (wr == 1) PG8_BAR;
        PG8_WAIT_V(2); PG8_BAR;
        PG8_STAGE(PG8_SB(1, 0), cB + kstep, voffB); PG8_STAGE(PG8_SA(1, 0), cA + kstep, voffA); PG8_STAGE(PG8_SB(1, 1), cB + hstep + kstep, voffB);
        PG8_WAIT_V(6); PG8_BAR;
    } else {
        PG8_STAGE(PG8_SB(0, 0), cB, voffB); PG8_STAGE(PG8_SA(0, 0), cA, voffA); PG8_STAGE(PG8_SB(0, 1), cB + hstep, voffB); PG8_STAGE(PG8_SA(0, 1), cA + hstep, voffA);
        if (wr == 1) PG8_BAR;
        PG8_WAIT_V(4); PG8_BAR;
        PG8_STAGE(PG8_SB(1, 0), cB + kstep, voffB); PG8_STAGE(PG8_SA(1, 0), cA + kstep, voffA); PG8_STAGE(PG8_SB(1, 1), cB + hstep + kstep, voffB);
        PG8_WAIT_V(6); PG8_BAR;
    }
    for (;;) {
        const bool has_next = S.next(ui + 1, nxt);
        const char* nA = has_next ? (const char*)g.A + (size_t)nxt.pm * tstep + nxt.koff : cA; const char* nB = has_next ? (const char*)g.Bt + (size_t)nxt.pn * tstep + nxt.koff : cB;
        for (int t = 0; t < nt; t += 2) {
            const bool last = (t == nt - 2);
            const char* a1 = cA + (size_t)(t + 1) * kstep;
            const char* a2 = last ? nA : cA + (size_t)(t + 2) * kstep; const char* b2 = last ? nB : cB + (size_t)(t + 2) * kstep;
            const char* a3 = a2 + kstep; const char* b3 = b2 + kstep;
            if (last && has_next) S.a_ready(nxt);
            if constexpr (SP2) {
            PG8_LDB(B0, 0, 0); PG8_LDB(B1, 0, 1); PG8_SCHED; PG8_LDA(At, 0, 0); PG8_STAGE(PG8_SA(1, 1), a1 + hstep, voffA);
            PG8_WAIT_V(8); PG8_WAIT_L(0); PG8_BAR; PG8_MMA(0, 0, At, B0); PG8_MMA(0, 1, At, B1); PG8_BAR; PG8_SCHED;
            PG8_LDA(At, 0, 1); PG8_STAGE(PG8_SB(0, 0), b2, voffB); PG8_STAGE(PG8_SB(0, 1), b2 + hstep, voffB); PG8_STAGE(PG8_SA(0, 0), a2, voffA);
            PG8_WAIT_V(8); PG8_WAIT_L(0); PG8_BAR; PG8_MMA(1, 0, At, B0); PG8_MMA(1, 1, At, B1); PG8_BAR; PG8_SCHED;
            PG8_LDB(B0, 1, 0); PG8_LDB(B1, 1, 1); PG8_SCHED; PG8_LDA(At, 1, 0); PG8_STAGE(PG8_SA(0, 1), a2 + hstep, voffA);
            PG8_WAIT_V(8); PG8_WAIT_L(0); PG8_BAR; PG8_MMA(0, 0, At, B0); PG8_MMA(0, 1, At, B1); PG8_BAR; PG8_SCHED;
            PG8_LDA(At, 1, 1); PG8_STAGE(PG8_SB(1, 0), b3, voffB); PG8_STAGE(PG8_SB(1, 1), b3 + hstep, voffB); PG8_STAGE(PG8_SA(1, 0), a3, voffA);
            PG8_WAIT_V(8); PG8_WAIT_L(0); PG8_BAR; PG8_MMA(1, 0, At, B0); PG8_MMA(1, 1, At, B1); PG8_BAR; PG8_SCHED;
            } else {
            PG8_LDB(B0, 0, 0); PG8_SCHED; PG8_LDA(At, 0, 0); PG8_STAGE(PG8_SA(1, 1), a1 + hstep, voffA);
            PG8_WAIT_L(8); PG8_BAR; PG8_WAIT_L(0); PG8_MMA(0, 0, At, B0); PG8_BAR; PG8_SCHED;
            PG8_LDB(B1, 0, 1); PG8_STAGE(PG8_SB(0, 0), b2, voffB);
            PG8_BAR; PG8_WAIT_L(0); PG8_MMA(0, 1, At, B1); PG8_BAR;
            PG8_LDA(At, 0, 1); PG8_STAGE(PG8_SA(0, 0), a2, voffA);
            PG8_BAR; PG8_WAIT_L(0); PG8_MMA(1, 0, At, B0); PG8_BAR; PG8_SCHED;
            PG8_STAGE(PG8_SB(0, 1), b2 + hstep, voffB);
            PG8_WAIT_V(6); PG8_BAR; PG8_MMA(1, 1, At, B1); PG8_BAR;
            PG8_LDB(B0, 1, 0); PG8_SCHED; PG8_LDA(At, 1, 0); PG8_STAGE(PG8_SA(0, 1), a2 + hstep, voffA);
            PG8_WAIT_L(8); PG8_BAR; PG8_WAIT_L(0); PG8_MMA(0, 0, At, B0); PG8_BAR; PG8_SCHED;
            PG8_LDB(B1, 1, 1); PG8_STAGE(PG8_SB(1, 0), b3, voffB);
            PG8_BAR; PG8_WAIT_L(0); PG8_MMA(0, 1, At, B1); PG8_BAR;
            PG8_LDA(At, 1, 1); PG8_STAGE(PG8_SA(1, 0), a3, voffA);
            PG8_BAR; PG8_WAIT_L(0); PG8_MMA(1, 0, At, B0); PG8_BAR; PG8_SCHED;
            PG8_STAGE(PG8_SB(1, 1), b3 + hstep, voffB);
            PG8_WAIT_V(6); PG8_BAR; PG8_MMA(1, 1, At, B1); PG8_BAR;
            }
        }
        if constexpr (ALIGN_EPI) { if (wr == 0) PG8_BAR; }
        if constexpr (!Epi::AFTER_DRAIN) { E(acc, cur, wr, wc, fr, fq); S.done(cur); }
        if (!has_next) break;
#pragma unroll
        for (int a = 0; a < 2; ++a)
#pragma unroll
            for (int b = 0; b < 2; ++b)
#pragma unroll
                for (int m = 0; m < 4; ++m)
#pragma unroll
                    for (int n = 0; n < 2; ++n) acc[a][b][m][n] = (f32x4){0.f, 0.f, 0.f, 0.f};
        cur = nxt; cA = nA; cB = nB; ++ui;
        if constexpr (ALIGN_EPI) { if (wr == 1) PG8_BAR; }
    }
    PG8_WAIT_V(0);
    if constexpr (!ALIGN_EPI) { if (wr == 0) PG8_BAR; }
    PG8_BAR;
    if constexpr (Epi::AFTER_DRAIN) { E.fused(acc, cur, wr, wc, fr, fq, lds, wid, lane); S.done(cur); }
#undef PG8_SA
#undef PG8_SB
#undef PG8_STAGE
#undef PG8_LDA
#undef PG8_LDB
#undef PG8_MMA
#undef PG8_WAIT_V
#undef PG8_WAIT_L
#undef PG8_BAR
#undef PG8_SCHED
}
}
#define NT 512
__device__ __forceinline__ bf16x8 lds_frag(const LAS bf16* p) { return *(const LAS bf16x8*)p; }

template <int CTRL> __device__ __forceinline__ float dpp_f(float v) { return __int_as_float(__builtin_amdgcn_update_dpp(0, __float_as_int(v), CTRL, 0xf, 0xf, false)); }
__device__ __forceinline__ float rdlane(float v, int l) { return __int_as_float(__builtin_amdgcn_readlane(__float_as_int(v), l)); }
template <int CTRL, int RM> __device__ __forceinline__ float dpp_rm(float v) { return __int_as_float(__builtin_amdgcn_update_dpp(0, __float_as_int(v), CTRL, RM, 0xf, false)); }
__device__ __forceinline__ float wave_sum_dpp(float v) {
    v += dpp_f<0x128>(v); v += dpp_f<0x124>(v); v += dpp_f<0x122>(v); v += dpp_f<0x121>(v);
    v += dpp_rm<0x142, 0xa>(v);
    v += dpp_rm<0x143, 0xc>(v);
    return rdlane(v, 63);
}

__device__ __forceinline__ int win_src_col(int n) {
    if (n < 2048) return n;
    if (n < 2560) return 2064 + (n - 2048);
    if (n < 2576) return 2048 + (n - 2560);
    if (n < 2816) return -1;
    return 2576 + (n - 2816);
}
__device__ __forceinline__ void transpose_tile(LAS float* tile, const float* src, int ld_src, bf16* dst, int K, int n0, int k0, bool winmap) {
    const int tid = opaque_tid();
    float v[16];
#pragma unroll
    for (int e = 0; e < 16; ++e) {
        const int idx = tid + NT * e, kk = idx >> 6, nn = idx & 63;
        const int col = winmap ? win_src_col(n0 + nn) : (n0 + nn);
        v[e] = col >= 0 ? src[(size_t)(k0 + kk) * ld_src + col] : 0.f;
    }
#pragma unroll
    for (int e = 0; e < 16; ++e) { const int idx = tid + NT * e; tile[(idx >> 6) * 65 + (idx & 63)] = v[e]; }
    __syncthreads();
#pragma unroll
    for (int e = 0; e < 8; ++e) {
        const int idx = tid + NT * e, nn = idx >> 6, kk = (idx & 63) * 2;
        *(unsigned*)(dst + (size_t)(n0 + nn) * K + k0 + kk) = pack2(tile[kk * 65 + nn], tile[(kk + 1) * 65 + nn]);
    }
    __syncthreads();
}
__device__ __forceinline__ void ln_row_store(const float (&v)[16], const float (&g)[16], const float (&b)[16], int lane, bf16* orow, float* frow) {
    float s = 0.f;
#pragma unroll
    for (int e = 0; e < 16; ++e) s += v[e];
    const float mu = wave_sum_dpp(s) * (1.0f / 1024.0f);
    float q = 0.f;
#pragma unroll
    for (int e = 0; e < 16; ++e) { const float d = v[e] - mu; q += d * d; }
    const float rs = rsqrtf(wave_sum_dpp(q) * (1.0f / 1024.0f) + 1e-5f);
#pragma unroll
    for (int hh = 0; hh < 2; ++hh) {
        const int c0 = hh * 512 + 8 * lane;
        float y[8];
#pragma unroll
        for (int e = 0; e < 8; ++e) y[e] = (v[hh * 8 + e] - mu) * rs * g[hh * 8 + e] + b[hh * 8 + e];
        if (orow) { u32x4 w; w.x = pack2(y[0], y[1]); w.y = pack2(y[2], y[3]); w.z = pack2(y[4], y[5]); w.w = pack2(y[6], y[7]); *(u32x4*)(orow + c0) = w; }
        if (frow) { *(f32x4*)(frow + c0) = (f32x4){y[0], y[1], y[2], y[3]}; *(f32x4*)(frow + c0 + 4) = (f32x4){y[4], y[5], y[6], y[7]}; }
    }
}
__device__ __forceinline__ void load_gb(const float* g, const float* b, int lane, float (&gv)[16], float (&bv)[16]) {
#pragma unroll
    for (int hh = 0; hh < 2; ++hh)
#pragma unroll
        for (int q4 = 0; q4 < 2; ++q4) {
            const f32x4 a = *(const f32x4*)(g + hh * 512 + 8 * lane + 4 * q4), c = *(const f32x4*)(b + hh * 512 + 8 * lane + 4 * q4);
#pragma unroll
            for (int e = 0; e < 4; ++e) { gv[hh * 8 + q4 * 4 + e] = a[e]; bv[hh * 8 + q4 * 4 + e] = c[e]; }
        }
}

__device__ __forceinline__ void phase_prologue(LAS unsigned char* lds, const Params& p) {
    const int tid = opaque_tid(), lane = tid & 63, w = tid >> 6, G = gridDim.x, bx = blockIdx.x;
    unsigned char* ws = p.ws;
    LAS float* tile = (LAS float*)lds;
    for (int t = bx; t < 3648; t += G) {
        if (t < 1024) { const int l = t >> 9, r = t & 511, nt = r >> 3, kt = r & 7; transpose_tile(tile, p.w_up + (size_t)l * 1024 * 4096, 4096, (bf16*)(ws + WS_WUP) + (size_t)l * 4096 * 1024, 1024, nt * 64, kt * 128, false); }
        else if (t < 2048) { const int u = t - 1024, l = u >> 9, r = u & 511, nt = r >> 5, kt = r & 31; transpose_tile(tile, p.w_down + (size_t)l * 4096 * 1024, 1024, (bf16*)(ws + WS_WDN) + (size_t)l * 1024 * 4096, 4096, nt * 64, kt * 128, false); }
        else if (t < 2304) { const int u = t - 2048, l = u >> 7, r = u & 127, nt = r >> 3, kt = r & 7; transpose_tile(tile, p.w_out + (size_t)l * 1024 * 1024, 1024, (bf16*)(ws + WS_WOUT) + (size_t)l * 1024 * 1024, 1024, nt * 64, kt * 128, false); }
        else if (t < 2432) { const int u = t - 2304, l = u >> 6, r = u & 63, nt = r >> 2, kt = r & 3; transpose_tile(tile, p.w_fp + (size_t)l * 512 * 1024, 1024, (bf16*)(ws + WS_WFP) + (size_t)l * 1024 * 512, 512, nt * 64, kt * 128, false); }
        else if (t < 2560) { const int u = t - 2432, l = u >> 6, r = u & 63, nt = r >> 2, kt = r & 3; transpose_tile(tile, p.w_dp + (size_t)l * 512 * 1024, 1024, (bf16*)(ws + WS_WDP) + (size_t)l * 1024 * 512, 512, nt * 64, kt * 128, false); }
        else { const int u = t - 2560, l = u / 544, r = u % 544, nt = r >> 3, kt = r & 7; transpose_tile(tile, p.w_in + (size_t)l * 1024 * INW, INW, (bf16*)(ws + WS_WIN) + (size_t)l * NIN * 1024, 1024, 512 + nt * 64, kt * 128, true); }
    }
    {
        LAS float* tab = (LAS float*)lds;
        LAS float* inb = tab + 128;
        if (tid < 128) tab[tid] = cospif((float)tid * (1.0f / 64.0f));
        __syncthreads();
        for (int it = bx; it < 2 * 4 * 256; it += G) {
            const int l = it >> 10, g = (it >> 8) & 3, k0 = (it & 255) * 4;
            __syncthreads();
            { const int kk = tid >> 7, c = tid & 127; inb[kk * 128 + c] = p.w_in[(size_t)l * 1024 * INW + (size_t)(k0 + kk) * INW + g * 128 + c]; }
            __syncthreads();
            const int kk = tid >> 7, pos = tid & 127;
            const int f = pos <= 64 ? pos : pos - 64, sh = pos <= 64 ? 0 : 96;
            float s = 0.f;
#pragma unroll 8
            for (int c = 0; c < 128; ++c) s += inb[kk * 128 + c] * tab[(c * f + sh) & 127];
            ((bf16*)(ws + WS_WIN))[(size_t)l * NIN * 1024 + (size_t)(g * 128 + pos) * 1024 + k0 + kk] = f2bf(s);
        }
        __syncthreads();
    }
    {
        float gv[16], bv[16]; load_gb(p.ln0g, p.ln0b, lane, gv, bv);
        for (int r0 = (bx * 8 + w) * 2; r0 < NROWS; r0 += G * 16) {
            float v[2][16]; bool pad[2];
#pragma unroll
            for (int k = 0; k < 2; ++k) {
                const int r = r0 + k; int b, pp; pos_of(r, b, pp); pad[k] = pp < PADR;
                const float* src = pp < 64 ? p.meta + (size_t)(pp < PADR ? 0 : pp - PADR) * 1024 : p.x + ((size_t)b * SEQ + (pp - 64)) * 1024;
#pragma unroll
                for (int hh = 0; hh < 2; ++hh) { const f32x4 a = *(const f32x4*)(src + hh * 512 + 8 * lane), c = *(const f32x4*)(src + hh * 512 + 8 * lane + 4);
#pragma unroll
                    for (int e = 0; e < 4; ++e) { v[k][hh * 8 + e] = a[e]; v[k][hh * 8 + 4 + e] = c[e]; } }
            }
#pragma unroll
            for (int k = 0; k < 2; ++k) {
                bf16* orow = (bf16*)(ws + WS_XB) + (size_t)(r0 + k) * 1024;
                if (pad[k]) { *(u32x4*)(orow + 8 * lane) = (u32x4){0u, 0u, 0u, 0u}; *(u32x4*)(orow + 512 + 8 * lane) = (u32x4){0u, 0u, 0u, 0u}; }
                else ln_row_store(v[k], gv, bv, lane, orow, nullptr);
            }
        }
    }
    {
        __syncthreads();
        LAS float* tab = (LAS float*)lds;
        for (int m = tid; m < LTOK; m += NT) tab[m] = cospif((float)m * (1.0f / 2056.0f));
        __syncthreads();
        bf16* Cm = (bf16*)(ws + WS_CM); bf16* Sm = (bf16*)(ws + WS_SM);
        const int total = 2 * DFT_M * (DFT_K / 2);
        for (int i = bx * NT + tid; i < total; i += G * NT) {
            const int par = i / (DFT_M * (DFT_K / 2)), rem = i % (DFT_M * (DFT_K / 2)), l = rem / (DFT_K / 2), k = (rem % (DFT_K / 2)) * 2;
            float c0 = 0.f, s0 = 0.f, c1 = 0.f, s1 = 0.f;
            if (l <= HALF_L / 2) {
                const int j0 = 2 * k + par, j1 = 2 * (k + 1) + par;
                if (j0 <= HALF_L) { const int m = (l * j0) % LTOK, ms = m >= 1028 ? m - 1028 : m + 3084; c0 = tab[m]; s0 = tab[ms]; }
                if (j1 <= HALF_L) { const int m = (l * j1) % LTOK, ms = m >= 1028 ? m - 1028 : m + 3084; c1 = tab[m]; s1 = tab[ms]; }
            }
            *(unsigned*)(Cm + ((size_t)par * DFT_M + l) * DFT_K + k) = pack2(c0, c1);
            *(unsigned*)(Sm + ((size_t)par * DFT_M + l) * DFT_K + k) = pack2(s0, s1);
        }
        __syncthreads();
    }
}

__device__ __forceinline__ void phase_fold(LAS unsigned char* lds, const Params& p) {
    const int tid = opaque_tid(), G = gridDim.x, bx = blockIdx.x;
    const bf16* UF = (const bf16*)(p.ws + WS_UF); bf16* EcT = (bf16*)(p.ws + WS_ECT); bf16* EsT = (bf16*)(p.ws + WS_EST);
    LAS float* tile = (LAS float*)lds;
    for (int it = bx; it < 32 * 36; it += G) {
        const int bg = it / 36, jt = it % 36, b = bg >> 2, g = bg & 3, j0 = jt * 64;
        bf16 u1[16], u2[16];
#pragma unroll
        for (int e = 0; e < 16; ++e) {
            const int idx = tid + NT * e, jj = idx >> 7, pos = idx & 127, j = j0 + jj;
            const int ja = j <= HALF_L ? j : 0, jb = (j > 0 && j < HALF_L) ? LTOK - j : ja;
            u1[e] = UF[(size_t)row_of(b, PADR + ja) * 512 + g * 128 + pos];
            u2[e] = UF[(size_t)row_of(b, PADR + jb) * 512 + g * 128 + pos];
        }
#pragma unroll
        for (int e = 0; e < 16; ++e) {
            const int idx = tid + NT * e, jj = idx >> 7, pos = idx & 127, j = j0 + jj;
            float val = 0.f;
            if (j <= HALF_L) {
                const float a = bf2f(u1[e]), c = bf2f(u2[e]);
                if (j == 0 || j == HALF_L) val = pos <= 64 ? a : 0.f;
                else val = pos <= 64 ? a + c : a - c;
            }
            tile[jj * 129 + pos] = val;
        }
        __syncthreads();
#pragma unroll
        for (int e = 0; e < 16; ++e) {
            const int idx = tid + NT * e, pos = idx >> 6, jj = idx & 63;
            const float v = tile[jj * 129 + pos];
            const int j = j0 + jj, par = j & 1, k = j >> 1;
            if (pos <= 64) EcT[((size_t)par * DFT_NC + bg * 65 + pos) * DFT_K + k] = f2bf(v);
            else EsT[((size_t)par * DFT_NS + bg * 63 + pos - 65) * DFT_K + k] = f2bf(v);
        }
        __syncthreads();
    }
    for (int par = 0; par < 2; ++par) {
        for (int i = bx * NT + tid; i < 224 * (DFT_K / 2); i += G * NT) ((unsigned*)(EcT + ((size_t)par * DFT_NC + 2080) * DFT_K))[i] = 0u;
        for (int i = bx * NT + tid; i < 32 * (DFT_K / 2); i += G * NT) ((unsigned*)(EsT + ((size_t)par * DFT_NS + 2016) * DFT_K))[i] = 0u;
    }
}

__device__ __forceinline__ void phase_unfold(LAS unsigned char* lds, const Params& p) {
    const int tid = opaque_tid(), lane = tid & 63, w = tid >> 6, G = gridDim.x, bx = blockIdx.x;
    const float* P = (const float*)(p.ws + WS_P); const float* Q = (const float*)(p.ws + WS_Q); bf16* FM = (bf16*)(p.ws + WS_UF);
    const float scale = 1.0f / sqrtf((float)LTOK * 128.0f);
    const int g = lane >> 4, cb = (8 * lane) & 127;
    LAS float* strip = (LAS float*)lds + w * (4 * 4 * 264);
    for (int r0 = (bx * 8 + w) * 4; r0 < NROWS; r0 += G * 32) {
        float sg[4]; bool pad[4], hi[4];
#pragma unroll
        for (int k = 0; k < 4; ++k) {
            const int r = r0 + k; int b, pp; pos_of(r, b, pp); pad[k] = pp < PADR;
            const int l = pad[k] ? 0 : pp - PADR, lf = l <= HALF_L ? l : LTOK - l; sg[k] = l <= HALF_L ? 1.f : -1.f;
            hi[k] = lf > HALF_L / 2; const int lh = hi[k] ? HALF_L - lf : lf;
            const float* Pe = P + (size_t)lh * DFT_NC + b * 260; const float* Po = Pe + (size_t)DFT_M * DFT_NC;
            const float* Qe = Q + (size_t)lh * DFT_NS + b * 252; const float* Qo = Qe + (size_t)DFT_M * DFT_NS;
            float va[5], vb[5], vc[4], vd[4];
#pragma unroll
            for (int q = 0; q < 5; ++q) { const int i = q * 64 + lane; va[q] = i < 260 ? Pe[i] : 0.f; vb[q] = i < 260 ? Po[i] : 0.f; }
#pragma unroll
            for (int q = 0; q < 4; ++q) { const int i = q * 64 + lane; vc[q] = i < 252 ? Qe[i] : 0.f; vd[q] = i < 252 ? Qo[i] : 0.f; }
            LAS float* sk = strip + k * (4 * 264);
#pragma unroll
            for (int q = 0; q < 5; ++q) { const int i = q * 64 + lane; if (i < 264) { sk[i] = va[q]; sk[264 + i] = vb[q]; } }
#pragma unroll
            for (int q = 0; q < 4; ++q) { const int i = q * 64 + lane; sk[528 + i] = vc[q]; sk[792 + i] = vd[q]; }
        }
        asm volatile("s_waitcnt lgkmcnt(0)" ::: "memory");
#pragma unroll
        for (int k = 0; k < 4; ++k) {
            const LAS float* sk = strip + k * (4 * 264);
            const float so = hi[k] ? -1.f : 1.f;
            bf16* orow = FM + (size_t)(r0 + k) * 512 + 8 * lane;
            float y[8];
#pragma unroll
            for (int e = 0; e < 8; ++e) {
                const int cp = cb + e, c = cp <= 64 ? cp : 128 - cp;
                const float pv = sk[g * 65 + c] + so * sk[264 + g * 65 + c];
                float qv = 0.f;
                if (c >= 1 && c <= 63) { const float qe = sk[528 + g * 63 + c - 1], qo = sk[792 + g * 63 + c - 1]; qv = hi[k] ? qo - qe : qe + qo; }
                y[e] = pad[k] ? 0.f : (cp <= 64 ? pv - sg[k] * qv : pv + sg[k] * qv) * scale;
            }
            u32x4 wv; wv.x = pack2(y[0], y[1]); wv.y = pack2(y[2], y[3]); wv.z = pack2(y[4], y[5]); wv.w = pack2(y[6], y[7]); *(u32x4*)orow = wv;
        }
        asm volatile("s_waitcnt lgkmcnt(0)" ::: "memory");
    }
}

__device__ __forceinline__ void phase_combine(const Params& p, int layer, int first_wg, int nwg, int nrows) {
    const int tid = opaque_tid(), lane = tid & 63, w = tid >> 6, G = nwg, bx = (int)blockIdx.x - first_wg;
    if (bx < 0) return;
    bf16* OF = (bf16*)(p.ws + WS_OF); const bf16* OB = (const bf16*)(p.ws + WS_OB); const bf16* Z = (const bf16*)(p.ws + WS_Z);
    const float* ng = p.dng + layer * 128 + ((8 * lane) & 127);
    float gv[8];
#pragma unroll
    for (int e = 0; e < 8; ++e) gv[e] = ng[e];
    for (int r0 = (bx * 8 + w) * 4; r0 < nrows; r0 += G * 32) {
        u32x4 ua[4], ub[4], uz[4];
#pragma unroll
        for (int k = 0; k < 4; ++k) { const size_t off = (size_t)(r0 + k) * 512 + 8 * lane; ua[k] = *(const u32x4*)(OF + off); ub[k] = *(const u32x4*)(OB + off); uz[k] = *(const u32x4*)(Z + off); }
#pragma unroll
        for (int k = 0; k < 4; ++k) {
            const size_t off = (size_t)(r0 + k) * 512 + 8 * lane;
            f32x4 a0, a1, b0, b1, z0, z1;
            pg8::unpack8(ua[k], a0, a1); pg8::unpack8(ub[k], b0, b1); pg8::unpack8(uz[k], z0, z1);
            a0 = a0 + b0; a1 = a1 + b1;
            float ss = a0[0] * a0[0] + a0[1] * a0[1] + a0[2] * a0[2] + a0[3] * a0[3] + a1[0] * a1[0] + a1[1] * a1[1] + a1[2] * a1[2] + a1[3] * a1[3];
            ss += dpp_f<0x128>(ss); ss += dpp_f<0x124>(ss); ss += dpp_f<0x122>(ss); ss += dpp_f<0x121>(ss);
            const float rn = rsqrtf(ss * (1.0f / 128.0f) + 1e-6f);
            float y[8];
#pragma unroll
            for (int e = 0; e < 4; ++e) { y[e] = a0[e] * rn * gv[e] * z0[e]; y[4 + e] = a1[e] * rn * gv[4 + e] * z1[e]; }
            u32x4 wv; wv.x = pack2(y[0], y[1]); wv.y = pack2(y[2], y[3]); wv.z = pack2(y[4], y[5]); wv.w = pack2(y[6], y[7]); *(u32x4*)(OF + off) = wv;
        }
    }
}

__device__ __forceinline__ void phase_ln(const Params& p, const float* g, const float* b, bool final_, const float* T, int nparts, int nrows) {
    const int tid = opaque_tid(), lane = tid & 63, w = tid >> 6, G = gridDim.x, bx = blockIdx.x;
    bf16* XB = (bf16*)(p.ws + WS_XB);
    float gv[16], bv[16]; load_gb(g, b, lane, gv, bv);
    for (int r0 = (bx * 8 + w) * 8; r0 < NMAIN; r0 += G * 64) {
        u32x4 u0[8], u1[8];
#pragma unroll
        for (int k = 0; k < 8; ++k) { bf16* row = XB + (size_t)(r0 + k) * 1024; u0[k] = *(const u32x4*)(row + 8 * lane); u1[k] = *(const u32x4*)(row + 512 + 8 * lane); }
#pragma unroll
        for (int k = 0; k < 8; ++k) {
            const int r = r0 + k;
            bf16* row = XB + (size_t)r * 1024;
            f32x4 a0, a1, c0, c1;
            pg8::unpack8(u0[k], a0, a1); pg8::unpack8(u1[k], c0, c1);
            float v[16];
#pragma unroll
            for (int e = 0; e < 4; ++e) { v[e] = a0[e]; v[4 + e] = a1[e]; v[8 + e] = c0[e]; v[12 + e] = c1[e]; }
            ln_row_store(v, gv, bv, lane, final_ ? nullptr : row, final_ ? p.out + (size_t)r * 1024 : nullptr);
        }
    }
    for (int r = NMAIN + bx * 8 + w; r < nrows; r += G * 8) {
        bf16* row = XB + (size_t)r * 1024;
        f32x4 a0, a1, c0, c1;
        pg8::unpack8(*(const u32x4*)(row + 8 * lane), a0, a1); pg8::unpack8(*(const u32x4*)(row + 512 + 8 * lane), c0, c1);
        float v[16];
#pragma unroll
        for (int e = 0; e < 4; ++e) { v[e] = a0[e]; v[4 + e] = a1[e]; v[8 + e] = c0[e]; v[12 + e] = c1[e]; }
        if (T != nullptr) {
            float acc[16];
#pragma unroll
            for (int e = 0; e < 16; ++e) acc[e] = 0.f;
            for (int pt0 = 0; pt0 < nparts; pt0 += 4) {
                f32x4 x[4][4];
#pragma unroll
                for (int q = 0; q < 4; ++q) {
                    const float* tp = T + ((size_t)(pt0 + q) * 512 + (r - NMAIN)) * 1024;
#pragma unroll
                    for (int hh = 0; hh < 2; ++hh) { x[q][hh * 2] = *(const f32x4*)(tp + hh * 512 + 8 * lane); x[q][hh * 2 + 1] = *(const f32x4*)(tp + hh * 512 + 8 * lane + 4); }
                }
#pragma unroll
                for (int q = 0; q < 4; ++q)
#pragma unroll
                    for (int hh = 0; hh < 2; ++hh)
#pragma unroll
                        for (int e = 0; e < 4; ++e) { acc[hh * 8 + e] += x[q][hh * 2][e]; acc[hh * 8 + 4 + e] += x[q][hh * 2 + 1][e]; }
            }
#pragma unroll
            for (int e = 0; e < 16; ++e) v[e] = ALPHA * v[e] + acc[e];
        }
        ln_row_store(v, gv, bv, lane, final_ ? nullptr : row, nullptr);
    }
}
constexpr int L_KS = 0, L_QS = 17408, L_VBT = 34816, L_KBET = 53248, L_KTT = 71680, L_ATT = 90112, L_TS = 99328, L_LM = 108544, L_TF = 126976;
constexpr int KP = 136, TP = 72;

__device__ __forceinline__ f32x4 mma16(const LAS bf16* A, int lda, const LAS bf16* Bt, int ldb, int ksteps, int lane, f32x4 acc) {
    const int l15 = lane & 15, quad = lane >> 4;
    const LAS bf16* ap = A + l15 * lda + quad * 8; const LAS bf16* bp = Bt + l15 * ldb + quad * 8;
    for (int ks = 0; ks < ksteps; ++ks) acc = __builtin_amdgcn_mfma_f32_16x16x32_bf16(lds_frag(ap + 32 * ks), lds_frag(bp + 32 * ks), acc, 0, 0, 0);
    return acc;
}

__device__ __forceinline__ int seg_start(int s) { return 16 * s; }

typedef float f32x2v __attribute__((ext_vector_type(2)));
struct D2Pre { unsigned xu[3][12]; float cw[3][5][2]; float bl, dl; };
__device__ __forceinline__ void d2_prefetch(D2Pre& r, const Params& p, int layer, int dir, int b, int h, int n, int w, int lane) {
    const int cn = dir ? 64 - n : n;
    const unsigned char* BD = p.ws + WS_BD + (size_t)row_of(b, 64 * cn) * 64 + (dir * 4 + h) * 4;
    const unsigned oboff = (unsigned)(dir ? 63 - lane : lane) * 64u;
    r.bl = *(const float*)(BD + (size_t)oboff); r.dl = *(const float*)(BD + 32 + (size_t)oboff);
    const unsigned l4 = (unsigned)lane * 4u, l8 = (unsigned)lane * 8u;
#pragma unroll
    for (int j = 0; j < 5; ++j) {
        const unsigned char* cp = (const unsigned char*)(p.conv_w + (size_t)(layer * 5 + j) * 1536 + h * 128);
#pragma unroll
        for (int t = 0; t < 3; ++t) { const f32x2v v = *(const f32x2v*)(cp + t * 2048 + (size_t)l8); r.cw[t][j][0] = v.x; r.cw[t][j][1] = v.y; }
    }
    const int pp0 = 64 * cn + 8 * w - 2;
    if (cn >= 2 && cn <= 63) {
        const unsigned char* rp = p.ws + WS_QKV + ((size_t)row_of(b, pp0) * 1536 + h * 128) * 2;
#pragma unroll
        for (int rr = 0; rr < 12; ++rr) {
            const unsigned ro = l4 + (unsigned)rr * 3072u;
#pragma unroll
            for (int t = 0; t < 3; ++t) r.xu[t][rr] = *(const unsigned*)(rp + t * 1024 + (size_t)ro);
        }
    } else {
#pragma unroll
        for (int rr = 0; rr < 12; ++rr) {
            const int pp = pp0 + rr;
#pragma unroll
            for (int t = 0; t < 3; ++t) {
                unsigned u = 0u;
                if (pp >= PADR && pp < LPAD) { const unsigned char* rp = p.ws + WS_QKV + ((size_t)row_of(b, pp) * 1536 + t * 512 + h * 128) * 2; u = *(const unsigned*)(rp + (size_t)l4); }
                r.xu[t][rr] = u;
            }
        }
    }
}
__device__ __forceinline__ u32x4 pack8dir(const float (&v)[8], int dir) {
    u32x4 a;
    if (dir) { a.x = pack2(v[7], v[6]); a.y = pack2(v[5], v[4]); a.z = pack2(v[3], v[2]); a.w = pack2(v[1], v[0]); }
    else { a.x = pack2(v[0], v[1]); a.y = pack2(v[2], v[3]); a.z = pack2(v[4], v[5]); a.w = pack2(v[6], v[7]); }
    return a;
}

__device__ __forceinline__ f32x4 bf4_to_f32(u32x2 v) { return (f32x4){__uint_as_float(v.x << 16), __uint_as_float(v.x & 0xffff0000u), __uint_as_float(v.y << 16), __uint_as_float(v.y & 0xffff0000u)}; }
template <int KS> __device__ __forceinline__ void ldfr(bf16x8 (&f)[KS], const LAS bf16* rowtile, int pitch, int lane) {
    const LAS bf16* q = rowtile + (lane & 15) * pitch + (lane >> 4) * 8;
#pragma unroll
    for (int ks = 0; ks < KS; ++ks) f[ks] = lds_frag(q + 32 * ks);
}
template <int KS> __device__ __forceinline__ f32x4 mmaf(const bf16x8 (&a)[KS], const bf16x8 (&b)[KS], f32x4 acc) {
#pragma unroll
    for (int ks = 0; ks < KS; ++ks) acc = __builtin_amdgcn_mfma_f32_16x16x32_bf16(a[ks], b[ks], acc, 0, 0, 0);
    return acc;
}
constexpr int L_GS = 145408, L_BS = 145664, L_ES = 145920;

__device__ __forceinline__ void d2_item(LAS unsigned char* lds, const Params& p, int layer, int dir, int b, int h, int n, unsigned char* slot, D2Pre& pre,
                                        bool has_next, int ndir, int nb, int nh, int nn) {
    const int tid = opaque_tid(), lane = tid & 63, w = __builtin_amdgcn_readfirstlane(tid >> 6), quad = lane >> 4, l15 = lane & 15;
    LAS bf16* kS = (LAS bf16*)(lds + L_KS); LAS bf16* qS = (LAS bf16*)(lds + L_QS); LAS bf16* vbT = (LAS bf16*)(lds + L_VBT); LAS bf16* kbeT = (LAS bf16*)(lds + L_KBET);
    LAS bf16* ktT = (LAS bf16*)(lds + L_KTT); LAS bf16* attS = (LAS bf16*)(lds + L_ATT); LAS bf16* TS = (LAS bf16*)(lds + L_TS);
    LAS float* Lm = (LAS float*)(lds + L_LM); LAS float* Tf = (LAS float*)(lds + L_TF);
    LAS bf16* valT = (LAS bf16*)(lds + L_LM); LAS bf16* kcdT = (LAS bf16*)(lds + L_TF);
    LAS float* gS = (LAS float*)(lds + L_GS); LAS float* bS = (LAS float*)(lds + L_BS); LAS float* eS = (LAS float*)(lds + L_ES);
    const int cn = dir ? 64 - n : n;
    float beta_l, gc_l, glast, eg_l, be_l, et_l;
    {
        const int oi = dir ? 63 - lane : lane; const bool valid = (64 * cn + oi) >= PADR;
        beta_l = valid ? sigmoidf_(pre.bl) : 0.f;
        const float xx = pre.dl + p.dt_bias[layer * 8 + dir * 4 + h];
        const float sp = xx > 15.f ? xx : __logf(1.0f + __expf(xx));
        float g = valid ? -__expf(p.a_log[layer * 8 + dir * 4 + h]) * sp : 0.f;
        { float t;
          t = __int_as_float(__builtin_amdgcn_update_dpp(0, __float_as_int(g), 0x111, 0xf, 0xf, true)); g += t;
          t = __int_as_float(__builtin_amdgcn_update_dpp(0, __float_as_int(g), 0x112, 0xf, 0xf, true)); g += t;
          t = __int_as_float(__builtin_amdgcn_update_dpp(0, __float_as_int(g), 0x114, 0xf, 0xf, true)); g += t;
          t = __int_as_float(__builtin_amdgcn_update_dpp(0, __float_as_int(g), 0x118, 0xf, 0xf, true)); g += t;
          const float r0 = rdlane(g, 15), r1 = rdlane(g, 31), r2 = rdlane(g, 47);
          const int row = lane >> 4;
          g += (row >= 1 ? r0 : 0.f) + (row >= 2 ? r1 : 0.f) + (row >= 3 ? r2 : 0.f); }
        gc_l = g; glast = rdlane(g, 63);
        eg_l = __expf(gc_l); be_l = beta_l * eg_l; et_l = __expf(glast - gc_l);
        if (w == 0) { gS[lane] = gc_l; bS[lane] = beta_l; eS[lane] = eg_l; }
    }
#ifndef EXP
#define EXP 0
#endif
#pragma unroll 1
    for (int repB = 0; repB < (EXP == 9 ? 2 : 1); ++repB) {
        const int i0 = dir ? 56 - 8 * w : 8 * w;
        const int npad = cn == 0 ? (PADR - 8 * w) : 0;
#pragma unroll
        for (int t = 0; t < 3; ++t) {
            f32x2v xv[12], cwv[5], y[8];
#pragma unroll
            for (int rr = 0; rr < 12; ++rr) { const unsigned u = pre.xu[t][rr]; xv[rr] = (f32x2v){__uint_as_float(u << 16), __uint_as_float(u & 0xffff0000u)}; }
#pragma unroll
            for (int j = 0; j < 5; ++j) cwv[j] = (f32x2v){pre.cw[t][j][0], pre.cw[t][j][1]};
#pragma unroll
            for (int tt = 0; tt < 8; ++tt) {
                f32x2v a = cwv[0] * xv[tt];
#pragma unroll
                for (int j = 1; j < 5; ++j) a = cwv[j] * xv[tt + j] + a;
                const f32x2v s = a * (-1.4426950408889634f);
                f32x2v e; e.x = __builtin_amdgcn_exp2f(s.x); e.y = __builtin_amdgcn_exp2f(s.y);
                e = e + 1.0f;
                f32x2v r; r.x = __builtin_amdgcn_rcpf(e.x); r.y = __builtin_amdgcn_rcpf(e.y);
                y[tt] = a * r;
            }
            if (npad > 0) {
#pragma unroll
                for (int tt = 0; tt < 8; ++tt) if (tt < npad) y[tt] = (f32x2v){0.f, 0.f};
            }
            if (t == 0) {
#pragma unroll
                for (int tt = 0; tt < 8; ++tt) {
                    const int oi = 8 * w + tt, i = dir ? 63 - oi : oi;
                    const f32x2v sq = y[tt] * y[tt];
                    const float rn = rsqrtf(wave_sum_dpp(sq.x + sq.y) + 1e-6f) * 0.08838834764831845f;
                    const f32x2v q = y[tt] * rn;
                    *(LAS unsigned*)(qS + i * KP + 2 * lane) = pack2(q.x, q.y);
                }
            } else if (t == 1) {
                float o0[8], o1[8], p0[8], p1[8];
#pragma unroll
                for (int tt = 0; tt < 8; ++tt) {
                    const int oi = 8 * w + tt, i = dir ? 63 - oi : oi;
                    const f32x2v sq = y[tt] * y[tt];
                    const float rn = rsqrtf(wave_sum_dpp(sq.x + sq.y) + 1e-6f);
                    const f32x2v k = y[tt] * rn;
                    *(LAS unsigned*)(kS + i * KP + 2 * lane) = pack2(k.x, k.y);
                    const float e1 = rdlane(be_l, i), e2 = rdlane(et_l, i);
                    const f32x2v ka = k * e1, kb = k * e2;
                    o0[tt] = ka.x; o1[tt] = ka.y; p0[tt] = kb.x; p1[tt] = kb.y;
                }
                *(LAS u32x4*)(kbeT + (2 * lane) * TP + i0) = pack8dir(o0, dir); *(LAS u32x4*)(kbeT + (2 * lane + 1) * TP + i0) = pack8dir(o1, dir);
                *(LAS u32x4*)(ktT + (2 * lane) * TP + i0) = pack8dir(p0, dir); *(LAS u32x4*)(ktT + (2 * lane + 1) * TP + i0) = pack8dir(p1, dir);
            } else {
                float o0[8], o1[8];
#pragma unroll
                for (int tt = 0; tt < 8; ++tt) {
                    const int oi = 8 * w + tt, i = dir ? 63 - oi : oi;
                    const f32x2v vb = y[tt] * rdlane(beta_l, i);
                    o0[tt] = vb.x; o1[tt] = vb.y;
                }
                *(LAS u32x4*)(vbT + (2 * lane) * TP + i0) = pack8dir(o0, dir); *(LAS u32x4*)(vbT + (2 * lane + 1) * TP + i0) = pack8dir(o1, dir);
            }
        }
    }
    lds_barrier();
    if (has_next) d2_prefetch(pre, p, layer, ndir, nb, nh, nn, w, lane);
#pragma unroll 1
    for (int repC = 0; repC < (EXP == 12 ? 2 : 1); ++repC) {
        const int mat = w >> 2, tr = w & 3;
        bf16x8 a[4], bq[4][4];
        ldfr<4>(a, (mat ? qS : kS) + 16 * tr * KP, KP, lane);
#pragma unroll
        for (int tc = 0; tc < 4; ++tc) if (tc <= tr) ldfr<4>(bq[tc], kS + 16 * tc * KP, KP, lane);
        const f32x4 g4 = *(const LAS f32x4*)(gS + 16 * tr + 4 * quad), b4 = *(const LAS f32x4*)(bS + 16 * tr + 4 * quad);
        float gcc[4];
#pragma unroll
        for (int tc = 0; tc < 4; ++tc) gcc[tc] = gS[16 * tc + l15];
#pragma unroll
        for (int tc = 0; tc < 4; ++tc) {
            f32x4 acc = (f32x4){0.f, 0.f, 0.f, 0.f};
            if (tc <= tr) acc = mmaf<4>(a, bq[tc], acc);
            const int c = 16 * tc + l15;
#pragma unroll
            for (int j = 0; j < 4; ++j) {
                const int i = 16 * tr + quad * 4 + j;
                const float dec = __expf(fminf(g4[j] - gcc[tc], 0.f));
                if (mat == 0) Lm[i * TP + c] = (i > c) ? b4[j] * acc[j] * dec : 0.f;
                else attS[i * TP + c] = (i >= c) ? f2bf(acc[j] * dec) : (bf16)0;
            }
        }
    }
    lds_barrier();
    if (w == 0) {
        const int blk = lane >> 4, c = lane & 15;
        const LAS float* Lb = Lm + (blk * 16) * TP + blk * 16;
        float t[16];
        t[0] = (c == 0) ? 1.f : 0.f;
        {
            f32x4 L4[8][2];
#pragma unroll
            for (int i = 1; i <= 8; ++i) { L4[i - 1][0] = *(const LAS f32x4*)(Lb + i * TP); L4[i - 1][1] = *(const LAS f32x4*)(Lb + i * TP + 4); }
#pragma unroll
            for (int i = 1; i <= 8; ++i) {
                float s0 = (i == c) ? 1.f : 0.f, s1 = 0.f;
#pragma unroll
                for (int j = 0; j < i; ++j) { const float lv = L4[i - 1][j >> 2][j & 3]; if (j & 1) s1 -= lv * t[j]; else s0 -= lv * t[j]; }
                t[i] = s0 + s1;
            }
        }
        {
            f32x4 L4[7][4];
#pragma unroll
            for (int i = 9; i <= 15; ++i)
#pragma unroll
                for (int q4 = 0; q4 < 4; ++q4) L4[i - 9][q4] = *(const LAS f32x4*)(Lb + i * TP + 4 * q4);
#pragma unroll
            for (int i = 9; i <= 15; ++i) {
                float s0 = (i == c) ? 1.f : 0.f, s1 = 0.f;
#pragma unroll
                for (int j = 0; j < i; ++j) { const float lv = L4[i - 9][j >> 2][j & 3]; if (j & 1) s1 -= lv * t[j]; else s0 -= lv * t[j]; }
                t[i] = s0 + s1;
            }
        }
#pragma unroll
        for (int i = 0; i < 16; ++i) { Tf[(blk * 16 + i) * TP + blk * 16 + c] = t[i]; TS[(blk * 16 + i) * TP + blk * 16 + c] = f2bf(t[i]); }
    } else {
        for (int idx = tid - 64; idx < 6 * 256; idx += NT - 64) {
            const int bk = idx >> 8, e = idx & 255, br = bk < 3 ? 0 : (bk < 5 ? 1 : 2), bc = bk < 3 ? bk + 1 : (bk < 5 ? bk - 1 : 3);
            Tf[(br * 16 + (e >> 4)) * TP + bc * 16 + (e & 15)] = 0.f; TS[(br * 16 + (e >> 4)) * TP + bc * 16 + (e & 15)] = (bf16)0;
        }
    }
    lds_barrier();
    {
        const int base = (tid >> 8) * 32, i = (tid >> 4) & 15, c = tid & 15;
        f32x4 a4[4]; float bv[16];
#pragma unroll
        for (int q4 = 0; q4 < 4; ++q4) a4[q4] = *(const LAS f32x4*)(Lm + (base + 16 + i) * TP + base + 4 * q4);
#pragma unroll
        for (int j = 0; j < 16; ++j) bv[j] = Tf[(base + j) * TP + base + c];
        float s = 0.f;
#pragma unroll
        for (int j = 0; j < 16; ++j) s += a4[j >> 2][j & 3] * bv[j];
        Lm[(base + i) * TP + base + 16 + c] = s;
    }
    lds_barrier();
    {
        const int base = (tid >> 8) * 32, i = (tid >> 4) & 15, c = tid & 15;
        f32x4 a4[4]; float bv[16];
#pragma unroll
        for (int q4 = 0; q4 < 4; ++q4) a4[q4] = *(const LAS f32x4*)(Tf + (base + 16 + i) * TP + base + 16 + 4 * q4);
#pragma unroll
        for (int j = 0; j < 16; ++j) bv[j] = Lm[(base + j) * TP + base + 16 + c];
        float s = 0.f;
#pragma unroll
        for (int j = 0; j < 16; ++j) s -= a4[j >> 2][j & 3] * bv[j];
        Tf[(base + 16 + i) * TP + base + c] = s; TS[(base + 16 + i) * TP + base + c] = f2bf(s);
    }
    lds_barrier();
    {
        const int c = tid & 31, i0 = tid >> 5;
        float bv[32];
#pragma unroll
        for (int j = 0; j < 32; ++j) bv[j] = Tf[j * TP + c];
#pragma unroll
        for (int rep = 0; rep < 2; ++rep) {
            const int ii = i0 + 16 * rep; f32x4 a4[8];
#pragma unroll
            for (int q4 = 0; q4 < 8; ++q4) a4[q4] = *(const LAS f32x4*)(Lm + (32 + ii) * TP + 4 * q4);
            float s0 = 0.f, s1 = 0.f, s2 = 0.f, s3 = 0.f;
#pragma unroll
            for (int j = 0; j < 32; j += 4) { s0 += a4[j >> 2][0] * bv[j]; s1 += a4[j >> 2][1] * bv[j + 1]; s2 += a4[j >> 2][2] * bv[j + 2]; s3 += a4[j >> 2][3] * bv[j + 3]; }
            Lm[ii * TP + 32 + c] = (s0 + s1) + (s2 + s3);
        }
    }
    lds_barrier();
    {
        const int c = tid & 31, i0 = tid >> 5;
        float bv[32];
#pragma unroll
        for (int j = 0; j < 32; ++j) bv[j] = Lm[j * TP + 32 + c];
#pragma unroll
        for (int rep = 0; rep < 2; ++rep) {
            const int ii = i0 + 16 * rep; f32x4 a4[8];
#pragma unroll
            for (int q4 = 0; q4 < 8; ++q4) a4[q4] = *(const LAS f32x4*)(Tf + (32 + ii) * TP + 32 + 4 * q4);
            float s0 = 0.f, s1 = 0.f, s2 = 0.f, s3 = 0.f;
#pragma unroll
            for (int j = 0; j < 32; j += 4) { s0 += a4[j >> 2][0] * bv[j]; s1 += a4[j >> 2][1] * bv[j + 1]; s2 += a4[j >> 2][2] * bv[j + 2]; s3 += a4[j >> 2][3] * bv[j + 3]; }
            TS[(32 + ii) * TP + c] = f2bf(-((s0 + s1) + (s2 + s3)));
        }
    }
    lds_barrier();
#pragma unroll 1
    for (int repE = 0; repE < (EXP == 14 ? 2 : 1); ++repE) {
        const int mat = w >> 2, rp = (w >> 1) & 1, ch = w & 1;
        bf16x8 a[2][2], bq[4][2];
#pragma unroll
        for (int r2 = 0; r2 < 2; ++r2) ldfr<2>(a[r2], TS + 16 * (2 * rp + r2) * TP, TP, lane);
#pragma unroll
        for (int tt = 0; tt < 4; ++tt) ldfr<2>(bq[tt], (mat ? kbeT : vbT) + 16 * (4 * ch + tt) * TP, TP, lane);
#pragma unroll
        for (int r2 = 0; r2 < 2; ++r2)
#pragma unroll
            for (int tt = 0; tt < 4; ++tt) {
                const int tr = 2 * rp + r2, tc = 4 * ch + tt;
                const f32x4 acc = mmaf<2>(a[r2], bq[tt], (f32x4){0.f, 0.f, 0.f, 0.f});
                u32x2 wv; wv.x = pack2(acc[0], acc[1]); wv.y = pack2(acc[2], acc[3]);
                *(LAS u32x2*)((mat ? kcdT : valT) + (16 * tc + l15) * TP + 16 * tr + quad * 4) = wv;
            }
    }
    lds_barrier();
#pragma unroll 1
    for (int repF = 0; repF < (EXP == 10 ? 2 : 1); ++repF) {
        unsigned char* sA = slot + SLOT_A; unsigned char* sQ = slot + SLOT_Q; unsigned char* sN = slot + SLOT_N; unsigned char* sO = slot + SLOT_O;
        {
            bf16x8 a[2], b1[4][2];
            ldfr<2>(a, kcdT + 16 * w * TP, TP, lane);
#pragma unroll
            for (int tc = 0; tc < 4; ++tc) ldfr<2>(b1[tc], attS + 16 * tc * TP, TP, lane);
            float eg[4]; u32x2 q4[4];
#pragma unroll
            for (int tc = 0; tc < 4; ++tc) { eg[tc] = eS[16 * tc + l15]; q4[tc] = *(const LAS u32x2*)(qS + (16 * tc + l15) * KP + 16 * w + 4 * quad); }
#pragma unroll
            for (int tc = 0; tc < 4; ++tc) {
                const f32x4 a1 = mmaf<2>(a, b1[tc], (f32x4){0.f, 0.f, 0.f, 0.f});
                const f32x4 qf = bf4_to_f32(q4[tc]);
                u32x2 wv; wv.x = pack2(qf[0] * eg[tc] - a1[0], qf[1] * eg[tc] - a1[1]); wv.y = pack2(qf[2] * eg[tc] - a1[2], qf[3] * eg[tc] - a1[3]);
                *(u32x2*)(sQ + (size_t)(unsigned)(((tc * 4 + (w >> 1)) * 64 + ((((w & 1) << 1) | (quad >> 1)) * 16 + l15)) * 16 + (quad & 1) * 8)) = wv;
            }
            const int tr = w & 3, tcb = (w >> 2) * 4;
            bf16x8 a2[2], b2[4][2];
            ldfr<2>(a2, attS + 16 * tr * TP, TP, lane);
#pragma unroll
            for (int tt = 0; tt < 4; ++tt) ldfr<2>(b2[tt], valT + 16 * (tcb + tt) * TP, TP, lane);
#pragma unroll
            for (int tt = 0; tt < 4; ++tt) {
                const f32x4 o = mmaf<2>(a2, b2[tt], (f32x4){0.f, 0.f, 0.f, 0.f});
                u32x2 wv; wv.x = pack2(o[0], o[1]); wv.y = pack2(o[2], o[3]);
                *(u32x2*)(sO + (size_t)(unsigned)((((tr * 8 + tcb + tt) * 64 + lane) * 4) * 2)) = wv;
            }
        }
        {
            const int rq = w >> 1, ch = w & 1;
            bf16x8 ak[2][2], at[2][2], bk[4][2], bv[4][2];
#pragma unroll
            for (int r2 = 0; r2 < 2; ++r2) { ldfr<2>(ak[r2], kcdT + 16 * (2 * rq + r2) * TP, TP, lane); ldfr<2>(at[r2], ktT + 16 * (2 * rq + r2) * TP, TP, lane); }
#pragma unroll
            for (int tt = 0; tt < 4; ++tt) { ldfr<2>(bk[tt], ktT + 16 * (4 * ch + tt) * TP, TP, lane); ldfr<2>(bv[tt], valT + 16 * (4 * ch + tt) * TP, TP, lane); }
#pragma unroll
            for (int r2 = 0; r2 < 2; ++r2)
#pragma unroll
                for (int tt = 0; tt < 4; ++tt) {
                    const int rt = 2 * rq + r2, tc = 4 * ch + tt;
                    const f32x4 a1 = mmaf<2>(ak[r2], bk[tt], (f32x4){0.f, 0.f, 0.f, 0.f}), a2 = mmaf<2>(at[r2], bv[tt], (f32x4){0.f, 0.f, 0.f, 0.f});
                    u32x2 wa; wa.x = pack2(-a1[0], -a1[1]); wa.y = pack2(-a1[2], -a1[3]);
                    *(u32x2*)(sA + (size_t)(unsigned)(((tc * 4 + (rt >> 1)) * 64 + ((((rt & 1) << 1) | (quad >> 1)) * 16 + l15)) * 16 + (quad & 1) * 8)) = wa;
                    u32x2 wv; wv.x = pack2(a2[0], a2[1]); wv.y = pack2(a2[2], a2[3]);
                    *(u32x2*)(sN + (size_t)(unsigned)((((rt * 8 + tc) * 64 + lane) * 4) * 2)) = wv;
                }
        }
        if (tid == 0) *(float*)(slot + SLOT_CD) = __expf(glast);
    }
    lds_barrier();
}

__device__ __forceinline__ void phase_d2(LAS unsigned char* lds, const Params& p, int layer, int c0, int nc, unsigned char* slots, int first_wg, int nwg) {
    const int tid = opaque_tid(), lane = tid & 63, w = __builtin_amdgcn_readfirstlane(tid >> 6);
    const int sh = nc == 16 ? 4 : 0, msk = nc - 1;
    const int nitems = 64 * nc;
    int it = (int)blockIdx.x - first_wg;
    if (it < 0) return;
    D2Pre pre;
    if (it < nitems) { const int seq = it >> sh, st = it & msk; d2_prefetch(pre, p, layer, seq >> 5, (seq >> 2) & 7, seq & 3, c0 + st, w, lane); }
    for (; it < nitems; it += nwg) {
        const int seq = it >> sh, st = it & msk, dir = seq >> 5, b = (seq >> 2) & 7, h = seq & 3;
        const int itn = it + nwg; const bool has_next = itn < nitems; const int nseq = has_next ? itn >> sh : 0, nst = has_next ? itn & msk : 0;
        d2_item(lds, p, layer, dir, b, h, c0 + st, slots + (size_t)it * SLOT, pre, has_next, nseq >> 5, (nseq >> 2) & 7, nseq & 3, c0 + nst);
    }
}

struct D3Regs { bf16x8 a[4], q[4]; u32x2 nt[2], ot; float cd; };
struct D3Off { unsigned a, q, n0, n1, o; };
__device__ __forceinline__ D3Off d3_offsets(int w, int lane, int slice) {
    D3Off f; const int l15 = lane & 15, quad = lane >> 4;
    f.a = SLOT_A + ((w * 4) * 64 + lane) * 16;
    f.q = SLOT_Q + (((w >> 1) * 4) * 64 + lane) * 16;
    f.n0 = SLOT_N + ((w * 8 + slice * 2 + 0) * 64 + lane) * 8;
    f.n1 = SLOT_N + ((w * 8 + slice * 2 + 1) * 64 + lane) * 8;
    f.o = SLOT_O + (((w >> 1) * 8 + slice * 2 + (w & 1)) * 64 + lane) * 8;
    return f;
}
__device__ __forceinline__ D3Regs d3_load(const unsigned char* slot, const D3Off& f) {
    D3Regs r;
#pragma unroll
    for (int ks = 0; ks < 4; ++ks) { r.a[ks] = *(const bf16x8*)(slot + (size_t)(f.a + 1024u * ks)); r.q[ks] = *(const bf16x8*)(slot + (size_t)(f.q + 1024u * ks)); }
    r.nt[0] = *(const u32x2*)(slot + (size_t)f.n0); r.nt[1] = *(const u32x2*)(slot + (size_t)f.n1);
    r.ot = *(const u32x2*)(slot + (size_t)f.o);
    r.cd = *(const float*)(slot + SLOT_CD);
    return r;
}

__device__ __forceinline__ void d3_step(const D3Regs& cur, f32x4 (&S)[2], LAS bf16* ST, int cb, unsigned char* obase, const unsigned (&ooff)[4], int w, int lane) {
    const int quad = lane >> 4, l15 = lane & 15, tco = w & 1;
    const LAS bf16* Sc = ST + cb * 32 * KP;
    bf16x8 bf0[4], bf1[4];
    ldfr<4>(bf0, Sc, KP, lane); ldfr<4>(bf1, Sc + 16 * KP, KP, lane);
    f32x4 a0 = S[0] * cur.cd + bf4_to_f32(cur.nt[0]), a1 = S[1] * cur.cd + bf4_to_f32(cur.nt[1]), ao = bf4_to_f32(cur.ot);
    if (tco) {
#pragma unroll
        for (int ks = 0; ks < 4; ++ks) {
            a0 = __builtin_amdgcn_mfma_f32_16x16x32_bf16(cur.a[ks], bf0[ks], a0, 0, 0, 0);
            a1 = __builtin_amdgcn_mfma_f32_16x16x32_bf16(cur.a[ks], bf1[ks], a1, 0, 0, 0);
            ao = __builtin_amdgcn_mfma_f32_16x16x32_bf16(cur.q[ks], bf1[ks], ao, 0, 0, 0);
        }
    } else {
#pragma unroll
        for (int ks = 0; ks < 4; ++ks) {
            a0 = __builtin_amdgcn_mfma_f32_16x16x32_bf16(cur.a[ks], bf0[ks], a0, 0, 0, 0);
            a1 = __builtin_amdgcn_mfma_f32_16x16x32_bf16(cur.a[ks], bf1[ks], a1, 0, 0, 0);
            ao = __builtin_amdgcn_mfma_f32_16x16x32_bf16(cur.q[ks], bf0[ks], ao, 0, 0, 0);
        }
    }
    S[0] = a0; S[1] = a1;
    LAS bf16* Sw = ST + (cb ^ 1) * 32 * KP;
#pragma unroll
    for (int tc = 0; tc < 2; ++tc) { u32x2 wv; wv.x = pack2(S[tc][0], S[tc][1]); wv.y = pack2(S[tc][2], S[tc][3]); *(LAS u32x2*)(Sw + (16 * tc + l15) * KP + 16 * w + quad * 4) = wv; }
#pragma unroll
    for (int j = 0; j < 4; ++j) *(bf16*)(obase + (size_t)ooff[j]) = f2bf(ao[j]);
    lds_barrier();
}

template <int NC> __device__ __forceinline__ void d3_run(LAS unsigned char* lds, const Params& p, int seg, bool dry) {
    const int tid = opaque_tid(), lane = tid & 63, w = __builtin_amdgcn_readfirstlane(tid >> 6), quad = lane >> 4, l15 = lane & 15;
    LAS bf16* ST = (LAS bf16*)lds;
    const int c0 = seg_start(seg);
    for (int wg = blockIdx.x; wg < 256; wg += gridDim.x) {
        const int xcd = wg & 7, idx = wg >> 3, seq = xcd * 8 + (idx >> 2), slice = idx & 3, dir = seq >> 5, b = (seq >> 2) & 7, h = seq & 3;
        float* sst = (float*)(p.ws + WS_SST) + ((size_t)wg * NT + tid) * 8;
        const unsigned char* slot0 = p.ws + WS_DS + (size_t)(seq * 16) * SLOT;
        const unsigned char* slotx = p.ws + WS_DSX + (size_t)seq * SLOT;
        D3Regs r[3];
        const D3Off off = d3_offsets(w, lane, slice);
        r[0] = d3_load(slot0, off); r[1] = d3_load(slot0 + SLOT, off); r[2] = d3_load(slot0 + 2 * SLOT, off);
        f32x4 S[2];
        if (seg == 0) { S[0] = (f32x4){0.f, 0.f, 0.f, 0.f}; S[1] = S[0]; } else { S[0] = *(const f32x4*)sst; S[1] = *(const f32x4*)(sst + 4); }
        lds_barrier();
#pragma unroll
        for (int tc = 0; tc < 2; ++tc) { u32x2 wv; wv.x = pack2(S[tc][0], S[tc][1]); wv.y = pack2(S[tc][2], S[tc][3]); *(LAS u32x2*)(ST + (16 * tc + l15) * KP + 16 * w + quad * 4) = wv; }
        lds_barrier();
        unsigned char* obuf = p.ws + (dir ? WS_OB : WS_OF);
        unsigned ooff[4];
#pragma unroll
        for (int j = 0; j < 4; ++j) { const int rj = 16 * (w >> 1) + quad * 4 + j; ooff[j] = (unsigned)((dir ? (63 - rj) : rj) * 1024 + (h * 128 + slice * 32 + 16 * (w & 1) + l15) * 2); }
        const unsigned char* sp = slot0 + 3 * SLOT;
        int ncur = c0;
#pragma unroll
        for (int st = 0; st < NC; ++st) {
            unsigned char* ob = obuf + (size_t)row_of(b, 64 * (dir ? 64 - ncur : ncur)) * 1024;
            d3_step(r[st % 3], S, ST, st & 1, ob, ooff, w, lane);
            if (st + 3 < NC) { r[st % 3] = d3_load(st + 3 == 16 ? slotx : sp, off); sp = opaque_ptr(sp + SLOT); }
            asm volatile("" : "+s"(ncur)); ncur += 1;
        }
        if (NC & 1) {
        }
        if (!dry) { *(f32x4*)sst = S[0]; *(f32x4*)(sst + 4) = S[1]; }
    }
}
__device__ __forceinline__ void phase_d3(LAS unsigned char* lds, const Params& p, int seg, bool dry = false) {
    if (seg == 3) d3_run<17>(lds, p, seg, dry); else d3_run<16>(lds, p, seg, dry);
}

__global__ void __launch_bounds__(NT, 2) fwd_kernel(Params p_in) {
    extern __shared__ __attribute__((aligned(16))) unsigned char lds_raw[];
    LAS unsigned char* lds = (LAS unsigned char*)lds_raw;
    cg::grid_group grid = cg::this_grid();
    typedef const __attribute__((address_space(4))) Params* KP;
    const KP kp = (KP)__builtin_amdgcn_kernarg_segment_ptr();
    volatile LAS unsigned* xst = (volatile LAS unsigned*)(lds + LDS_BYTES - 16);
    if (threadIdx.x < 4) xst[threadIdx.x] = 0u;
    __syncthreads();
    if (blockIdx.x == 0) { for (int i = threadIdx.x; i < XCD_BAR_WORDS; i += NT) ((unsigned*)(p_in.ws + WS_BAR))[i] = 0u; __threadfence(); }
    grid.sync();
    XcdBarrier xbar = xcd_barrier_post((unsigned*)(p_in.ws + WS_BAR), xst);
    const int G = gridDim.x, bx = blockIdx.x;
    const int ph_lo = p_in.ph_lo, ph_hi = p_in.ph_hi;
    for (int ph0 = ph_lo; ph0 < ph_hi; ++ph0) {
        int ph = ph0; asm volatile("" : "+s"(ph));
        const Params& p = p_in;
        unsigned char* ws = p.ws;
#ifndef EXP
#define EXP 0
#endif
        if (ph == 0) { phase_prologue(lds, p); if (EXP == 2) { __syncthreads(); phase_prologue(lds, p); } }
        else {
            const int layer = (ph - 1) / 18, sub0r = (ph - 1) % 18, sub0 = sub0r <= 12 ? sub0r : sub0r + 1;
            const int sub = sub0 <= 3 ? sub0 : (sub0 <= 10 ? sub0 + 1 : (sub0 == 11 ? 14 : sub0 + 4));
            bool is_gemm = false; int ncall = 1; int tailsplit = 0;
            int d2_c0 = -1, d2_nc = 16, d2_first = 0, d2_nwg = G; unsigned char* d2_slots = ws + WS_DS;
            pg8::Gemm g{nullptr, nullptr, 0, 0, 0}; pg8::Epi E{}; int swz = 1;
            bf16* XB = (bf16*)(ws + WS_XB);
            const int MR = (layer == 1) ? NMAIN : NROWS;
            if (sub == 0) { is_gemm = true; g = pg8::Gemm{XB, (bf16*)(ws + WS_WIN) + (size_t)layer * NIN * 1024, NROWS, N1, 1024, 1024};
                E.mode = pg8::EP_PROJ1; E.uf = (bf16*)(ws + WS_UF); E.qkv = (bf16*)(ws + WS_QKV); E.z = (bf16*)(ws + WS_Z); E.bd = (float*)(ws + WS_BD); }
            else if (sub == 1) { phase_fold(lds, p); if (EXP == 5) { __syncthreads(); phase_fold(lds, p); } }
            else if (sub == 2) { is_gemm = true; ncall = 4; swz = 0; }
            else if (sub == 3) { phase_unfold(lds, p); if (EXP == 5) phase_unfold(lds, p); d2_c0 = 0; }
            else if (sub < 12) { const int s = (sub - 4) >> 1; if ((sub - 4) & 1) { if (EXP == 4) { phase_d3(lds, p, s, true); __syncthreads(); } phase_d3(lds, p, s); } else { d2_c0 = 16 * s; } }
            else if (sub == 14) { is_gemm = true; g = pg8::Gemm{XB, (bf16*)(ws + WS_WIN) + (size_t)layer * NIN * 1024 + (size_t)N1 * 1024, MR, N2, 1024, 1024};
                E.mode = pg8::EP_SIGM; E.o = (bf16*)(ws + WS_G); E.ldc = 2048; }

            else if (sub == 16) { is_gemm = true; g = pg8::Gemm{(bf16*)(ws + WS_UF), (bf16*)(ws + WS_WFP) + (size_t)layer * 1024 * 512, MR, 1024, 512, 512};
                E.mode = pg8::EP_MERGE0; E.o = (bf16*)(ws + WS_TMP); E.ldc = 1024; E.gate = (bf16*)(ws + WS_G); ncall = 2; }
            else if (sub == 17) { is_gemm = true; g = pg8::Gemm{(bf16*)(ws + WS_OF), (bf16*)(ws + WS_WDP) + (size_t)layer * 1024 * 512, MR, 1024, 512, 512};
                E.mode = pg8::EP_MERGE1; E.o = (bf16*)(ws + WS_TMP); E.ldc = 1024; E.gate = (bf16*)(ws + WS_G) + 1024; }
            else if (sub == 18) { is_gemm = true; g = pg8::Gemm{(bf16*)(ws + WS_TMP), (bf16*)(ws + WS_WOUT) + (size_t)layer * 1024 * 1024, MR, 1024, 1024, 1024};
                E.mode = pg8::EP_RES; E.o = XB; E.ldc = 1024; g.M = NMAIN; if (layer == 0) { ncall = 2; tailsplit = 256; } }
            else if (sub == 19) phase_ln(p, p.ln1g + layer * 1024, p.ln1b + layer * 1024, false, layer == 0 ? (const float*)(ws + WS_TOUT) : nullptr, 4, MR);
            else if (sub == 20) { is_gemm = true; g = pg8::Gemm{XB, (bf16*)(ws + WS_WUP) + (size_t)layer * 4096 * 1024, MR, DFF, 1024, 1024};
                E.mode = pg8::EP_SQRELU; E.o = (bf16*)(ws + WS_H); E.ldc = DFF; }
            else if (sub == 21) { is_gemm = true; g = pg8::Gemm{(bf16*)(ws + WS_H), (bf16*)(ws + WS_WDN) + (size_t)layer * 1024 * 4096, MR, 1024, DFF, DFF};
                E.mode = pg8::EP_RES; E.o = XB; E.ldc = 1024; g.M = NMAIN; if (layer == 0) { ncall = 2; tailsplit = 512; } }
            else phase_ln(p, p.ln2g + layer * 1024, p.ln2b + layer * 1024, layer == 1, layer == 0 ? (const float*)(ws + WS_TDN) : nullptr, 8, MR);
            if (is_gemm) {
                for (int call = 0; call < ncall; ++call) {
                    int c = bx;
                    if (sub == 2) {
                        const int par = call & 1, off = call == 0 ? 0 : (call == 1 ? 45 : (call == 2 ? 90 : 130));
                        if (call < 2) g = pg8::Gemm{(bf16*)(ws + WS_CM) + (size_t)par * DFT_M * DFT_K, (bf16*)(ws + WS_ECT) + (size_t)par * DFT_NC * DFT_K, DFT_M, DFT_NC, DFT_K, DFT_K};
                        else g = pg8::Gemm{(bf16*)(ws + WS_SM) + (size_t)par * DFT_M * DFT_K, (bf16*)(ws + WS_EST) + (size_t)par * DFT_NS * DFT_K, DFT_M, DFT_NS, DFT_K, DFT_K};
                        E.mode = pg8::EP_F32; E.ldc = g.N;
                        E.of32 = (float*)(ws + (call < 2 ? WS_P : WS_Q)) + (size_t)par * DFT_M * g.N;
                        c = (bx + G - (off % G)) % G;
                    }
                    if (sub == 16 && call == 1) { g.A = (bf16*)(ws + WS_OF); g.Bt = (bf16*)(ws + WS_WDP) + (size_t)layer * 1024 * 512; E.mode = pg8::EP_MERGE1; E.gate = (bf16*)(ws + WS_G) + 1024; }
                    pg8::Order S; S.init(g.M, g.N, G, c, swz);
                    if (tailsplit && call == 1) {
                        g.K = tailsplit; E.mode = pg8::EP_PART; E.of32 = (float*)(ws + (sub == 18 ? WS_TOUT : WS_TDN)); E.goff = NMAIN;
                        S.init_split(2, NMAIN / 256, 1024, g.ld / tailsplit, tailsplit * 2, G, c);
                    }
                    __syncthreads();
                    pg8::gemm_phase<pg8::Epi, pg8::Order, true, true>(lds, g, S, E);
                    __syncthreads();
                    if (sub == 2 && call == 3) { d2_c0 = 64; d2_nc = 1; d2_slots = ws + WS_DSX; if (G >= 234) { d2_first = 170; d2_nwg = G - 170; } }
                    if (sub == 14) {
                        const int nun = (g.M / 256) * (g.N / 256), tailw = nun % G;
                        __syncthreads();
                        const int cf = (tailw > 0 && tailw < G / 2) ? tailw : 0; phase_combine(p, layer, cf, G - cf, MR);
                    }
                    if (EXP == 6 && sub == 20 && call == 0) { ncall = 2; }
                    if (EXP == 7 && sub == 0 && call == 0) { ncall = 2; }
                }
            }
            if (d2_c0 >= 0) { __syncthreads(); phase_d2(lds, p, layer, d2_c0, d2_nc, d2_slots, d2_first, d2_nwg); }
        }
        if (ph0 + 1 < ph_hi) { xcd_barrier(xbar); if (EXP == 1) xcd_barrier(xbar); }
    }
}

#ifndef N_LAUNCH_MODE
#define N_LAUNCH_MODE 1
#endif
extern "C" void kernel_launch(void* const* d_in, const int* in_sizes, int n_in, void* d_out, int out_size, void* d_ws, size_t ws_size, hipStream_t stream) {
    static int grid = 0;
    if (grid == 0) {
        if (n_in != 18 || ws_size < WS_END) { fprintf(stderr, "kernel_launch: unexpected n_in %d / ws_size %zu (need %zu)\n", n_in, ws_size, (size_t)WS_END); grid = -1; return; }
        int dev = 0, cus = 0, per_cu = 0;
        hipGetDevice(&dev); hipDeviceGetAttribute(&cus, hipDeviceAttributeMultiprocessorCount, dev);
        if (hipFuncSetAttribute((const void*)fwd_kernel, hipFuncAttributeMaxDynamicSharedMemorySize, LDS_BYTES) != hipSuccess) { fprintf(stderr, "kernel_launch: hipFuncSetAttribute failed\n"); grid = -1; return; }
        hipOccupancyMaxActiveBlocksPerMultiprocessor(&per_cu, (const void*)fwd_kernel, NT, LDS_BYTES);
        if (per_cu < 1) { fprintf(stderr, "kernel_launch: occupancy query says %d blocks per CU\n", per_cu); per_cu = 1; }
        (void)hipGetLastError();
        grid = cus * 1;
        fprintf(stderr, "kernel_launch: grid %d (cus %d, per_cu %d)\n", grid, cus, per_cu);
    }
    if (grid < 0) return;
    Params p{};
    const float** pf = (const float**)&p;
    for (int i = 0; i < 18; ++i) pf[i] = (const float*)d_in[i];
    p.out = (float*)d_out; p.ws = (unsigned char*)d_ws;
    const int NPH = 37;
    if (N_LAUNCH_MODE == 1) {
        p.ph_lo = 0; p.ph_hi = NPH;
        void* args[] = {&p};
        hipError_t e = hipLaunchCooperativeKernel((const void*)fwd_kernel, dim3(grid), dim3(NT), args, LDS_BYTES, stream);
        if (e != hipSuccess) fprintf(stderr, "cooperative launch failed: %s (grid %d)\n", hipGetErrorString(e), grid);
    } else {
        for (int ph = 0; ph < NPH; ++ph) {
            p.ph_lo = ph; p.ph_hi = ph + 1;
            void* args[] = {&p};
            hipError_t e = hipLaunchCooperativeKernel((const void*)fwd_kernel, dim3(grid), dim3(NT), args, LDS_BYTES, stream);
            if (e != hipSuccess) { fprintf(stderr, "launch %d failed: %s\n", ph, hipGetErrorString(e)); break; }
        }
    }
}
```
